# Optimizing an MI355X kernel written in HIP

```python
import jax, jax.numpy as jnp
from jax import lax
import numpy as np

D_MODEL = 1024
BATCH = 8
SEQ = 4096
DEPTH = 2

N_A = DEPTH // 2
N_B = DEPTH - N_A
N_META = 16
HEAD_DIM = 64
N_HEADS_A = D_MODEL // HEAD_DIM
LORA_DECAY = 64
LORA_AAA = 64
LORA_GATE = 128
GN_EPS = 64e-5
N_HEADS_Q = D_MODEL // HEAD_DIM
N_HEADS_KV = 4
GROUP = N_HEADS_Q // N_HEADS_KV
WINDOW = 128
BLOCK = 128
PAD_FRONT = BLOCK - N_META
ROPE_THETA = 10000.0
D_FF = 4 * D_MODEL
ALPHA = (2.0 * DEPTH) ** 0.25
BETA = (8.0 * DEPTH) ** -0.25
LN_EPS = 1e-5

kernel_name = "yoco_rwkv7_swa_sink_hybrid"


def layer_norm(x, g, b):
    xf = x.astype(jnp.float32)
    mu = jnp.mean(xf, axis=-1, keepdims=True)
    xc = xf - mu
    var = jnp.mean(xc * xc, axis=-1, keepdims=True)
    y = xc * lax.rsqrt(var + LN_EPS) * g.astype(jnp.float32) + b.astype(jnp.float32)
    return y.astype(x.dtype)


def rope_tables(length):
    inv_freq = 1.0 / (ROPE_THETA ** (jnp.arange(0, HEAD_DIM, 2, dtype=jnp.float32) / HEAD_DIM))
    ang = jnp.arange(length, dtype=jnp.float32)[:, None] * inv_freq[None, :]
    return jnp.cos(ang), jnp.sin(ang)


def apply_rope(t, cos, sin):
    tf = t.astype(jnp.float32)
    t1, t2 = jnp.split(tf, 2, axis=-1)
    c = cos[None, :, None, :]
    s = sin[None, :, None, :]
    out = jnp.concatenate([t1 * c - t2 * s, t2 * c + t1 * s], axis=-1)
    return out.astype(t.dtype)


def sq_relu_mlp(x, w_up, w_down):
    h = jax.nn.relu(x @ w_up)
    return (h * h) @ w_down


def rwkv7_time_mix(x, mu, w_r, w_k, w_v, w_o, w0, w1, w2, a0, a1, a2, g1, g2,
                   k_k, k_a, r_k, gn_w, gn_b):
    bsz, length, d = x.shape
    H, N = N_HEADS_A, HEAD_DIM
    x_prev = jnp.pad(x, ((0, 0), (1, 0), (0, 0)))[:, :-1]
    xx = x_prev - x
    xr = x + xx * mu[0]
    xw = x + xx * mu[1]
    xk = x + xx * mu[2]
    xv = x + xx * mu[3]
    xa = x + xx * mu[4]
    xg = x + xx * mu[5]
    r = xr @ w_r
    k = xk @ w_k
    v = xv @ w_v
    w = -jax.nn.softplus(-(w0 + jnp.tanh(xw @ w1) @ w2)) - 0.5
    a = jax.nn.sigmoid(a0 + (xa @ a1) @ a2)
    g = jax.nn.sigmoid(xg @ g1) @ g2
    f32 = jnp.float32
    kk = (k * k_k).reshape(bsz, length, H, N).astype(f32)
    kk = kk / jnp.maximum(jnp.linalg.norm(kk, axis=-1, keepdims=True), 1e-12)
    k = k * (1.0 + (a - 1.0) * k_a)
    rh = r.reshape(bsz, length, H, N).astype(f32)
    kh = k.reshape(bsz, length, H, N).astype(f32)
    vh = v.reshape(bsz, length, H, N).astype(f32)
    ah = a.reshape(bsz, length, H, N).astype(f32)
    decay = jnp.exp(-jnp.exp(w.reshape(bsz, length, H, N).astype(f32)))
    seq_first = lambda t: jnp.transpose(t, (1, 0, 2, 3))
    inputs = (seq_first(rh), seq_first(decay), seq_first(kh), seq_first(vh),
              seq_first(-kk), seq_first(kk * ah))

    def step(state, inp):
        r_t, w_t, k_t, v_t, a_t, b_t = inp
        sa = jnp.einsum('bhij,bhj->bhi', state, a_t)
        state = (state * w_t[:, :, None, :] + sa[..., None] * b_t[:, :, None, :]
                 + v_t[..., None] * k_t[:, :, None, :])
        y = jnp.einsum('bhij,bhj->bhi', state, r_t)
        return state, y

    state0 = jnp.zeros((bsz, H, N, N), f32)
    _, ys = lax.scan(step, state0, inputs)
    y = jnp.transpose(ys, (1, 0, 2, 3))
    ym = jnp.mean(y, axis=-1, keepdims=True)
    yc = y - ym
    yv = jnp.mean(yc * yc, axis=-1, keepdims=True)
    y = (yc * lax.rsqrt(yv + GN_EPS) * gn_w.reshape(H, N).astype(f32)
         + gn_b.reshape(H, N).astype(f32))
    bonus = jnp.sum(rh * kh * r_k.astype(f32), axis=-1, keepdims=True) * vh
    o = (y + bonus).reshape(bsz, length, d).astype(x.dtype) * g
    return o @ w_o


def to_blocks(t):
    pad = [(0, 0), (PAD_FRONT, 0)] + [(0, 0)] * (t.ndim - 2)
    t = jnp.pad(t, pad)
    return t.reshape(t.shape[0], -1, BLOCK, *t.shape[2:])


def with_prev_block(tb):
    pad = [(0, 0), (1, 0)] + [(0, 0)] * (tb.ndim - 2)
    prev = jnp.pad(tb, pad)[:, :-1]
    return jnp.concatenate([prev, tb], axis=2)


def band_mask(nb):
    qi = jnp.arange(BLOCK)[:, None]
    kj = jnp.arange(2 * BLOCK)[None, :]
    rel = BLOCK + qi - kj
    in_window = (rel >= 0) & (rel < WINDOW)
    key_pos = (jnp.arange(nb)[:, None] - 1) * BLOCK + jnp.arange(2 * BLOCK)[None, :]
    valid = key_pos >= PAD_FRONT
    return in_window[None] & valid[:, None, :]


def shared_kv(x, w_k, w_v, cos, sin):
    bsz, length, _ = x.shape
    k = (x @ w_k).reshape(bsz, length, N_HEADS_KV, HEAD_DIM)
    v = (x @ w_v).reshape(bsz, length, N_HEADS_KV, HEAD_DIM)
    k = apply_rope(k, cos, sin)
    return with_prev_block(to_blocks(k)), with_prev_block(to_blocks(v))


def swa_sink_attention(x, w_q, sinks, w_o, kb, vb, cos, sin, mask):
    bsz, length, d = x.shape
    q = (x @ w_q).reshape(bsz, length, N_HEADS_Q, HEAD_DIM)
    q = apply_rope(q, cos, sin)
    qb = to_blocks(q)
    nb = qb.shape[1]
    qb = qb.reshape(bsz, nb, BLOCK, N_HEADS_KV, GROUP, HEAD_DIM)
    f32 = jnp.float32
    s = jnp.einsum('bnqhgd,bnshd->bnhgqs', qb.astype(f32), kb.astype(f32)) * (HEAD_DIM ** -0.5)
    s = jnp.where(mask[None, :, None, None], s, -jnp.inf)
    sink = sinks.reshape(N_HEADS_KV, GROUP).astype(f32)[None, None, :, :, None]
    m = jnp.maximum(jnp.max(s, axis=-1), sink)
    p = jnp.exp(s - m[..., None])
    denom = jnp.sum(p, axis=-1) + jnp.exp(sink - m)
    p = p / denom[..., None]
    o = jnp.einsum('bnhgqs,bnshd->bnqhgd', p, vb.astype(f32))
    o = o.reshape(bsz, nb * BLOCK, d)[:, PAD_FRONT:].astype(x.dtype)
    return o @ w_o


def setup_inputs(seed: int = 0) -> dict:
    key = jax.random.key(seed)
    ks = iter(jax.random.split(key, 40))
    D = D_MODEL
    inv = D ** -0.5

    def nrm(shape, scale):
        return jax.random.normal(next(ks), shape, jnp.float32) * scale

    return {
        "x": nrm((BATCH, SEQ, D), 1.0),
        "meta_tokens": nrm((N_META, D), 1.0),
        "a_mu": jax.random.uniform(next(ks), (N_A, 6, D), jnp.float32),
        "a_w_r": nrm((N_A, D, D), inv),
        "a_w_k": nrm((N_A, D, D), inv),
        "a_w_v": nrm((N_A, D, D), inv * BETA),
        "a_w_o": nrm((N_A, D, D), inv * BETA),
        "a_w0": jax.random.uniform(next(ks), (N_A, D), jnp.float32, -6.0, 1.0),
        "a_w1": nrm((N_A, D, LORA_DECAY), inv),
        "a_w2": nrm((N_A, LORA_DECAY, D), 0.1 * LORA_DECAY ** -0.5),
        "a_a0": nrm((N_A, D), 0.5),
        "a_a1": nrm((N_A, D, LORA_AAA), inv),
        "a_a2": nrm((N_A, LORA_AAA, D), LORA_AAA ** -0.5),
        "a_g1": nrm((N_A, D, LORA_GATE), inv),
        "a_g2": nrm((N_A, LORA_GATE, D), LORA_GATE ** -0.5),
        "a_k_k": 0.85 + nrm((N_A, D), 0.05),
        "a_k_a": 1.0 + nrm((N_A, D), 0.05),
        "a_r_k": nrm((N_A, N_HEADS_A, HEAD_DIM), 0.1),
        "a_gn_w": 1.0 + nrm((N_A, D), 0.05),
        "a_gn_b": nrm((N_A, D), 0.02),
        "kv_w_k": nrm((D, N_HEADS_KV * HEAD_DIM), inv),
        "kv_w_v": nrm((D, N_HEADS_KV * HEAD_DIM), inv * BETA),
        "b_w_q": nrm((N_B, D, N_HEADS_Q * HEAD_DIM), inv),
        "b_sinks": nrm((N_B, N_HEADS_Q), 1.0),
        "b_w_o": nrm((N_B, N_HEADS_Q * HEAD_DIM, D), inv * BETA),
        "mlp_w_up": nrm((DEPTH, D, D_FF), inv),
        "mlp_w_down": nrm((DEPTH, D_FF, D), D_FF ** -0.5 * BETA),
        "ln_g": 1.0 + nrm((DEPTH, 2, D), 0.05),
        "ln_b": nrm((DEPTH, 2, D), 0.02),
    }


def reference(x, meta_tokens, a_mu, a_w_r, a_w_k, a_w_v, a_w_o, a_w0, a_w1, a_w2,
              a_a0, a_a1, a_a2, a_g1, a_g2, a_k_k, a_k_a, a_r_k, a_gn_w, a_gn_b,
              kv_w_k, kv_w_v, b_w_q, b_sinks, b_w_o, mlp_w_up, mlp_w_down, ln_g, ln_b):
    bsz = x.shape[0]
    meta = jnp.broadcast_to(meta_tokens[None].astype(x.dtype), (bsz, N_META, x.shape[2]))
    h = jnp.concatenate([meta, x], axis=1)
    length = h.shape[1]
    cos, sin = rope_tables(length)
    nb = (length + PAD_FRONT) // BLOCK
    mask = band_mask(nb)
    kb = vb = None
    for i in range(DEPTH):
        if i < N_A:
            j = i
            mix = rwkv7_time_mix(h, a_mu[j], a_w_r[j], a_w_k[j], a_w_v[j], a_w_o[j],
                                 a_w0[j], a_w1[j], a_w2[j], a_a0[j], a_a1[j], a_a2[j],
                                 a_g1[j], a_g2[j], a_k_k[j], a_k_a[j], a_r_k[j],
                                 a_gn_w[j], a_gn_b[j])
        else:
            if i == N_A:
                kb, vb = shared_kv(h, kv_w_k, kv_w_v, cos, sin)
            j = i - N_A
            mix = swa_sink_attention(h, b_w_q[j], b_sinks[j], b_w_o[j], kb, vb, cos, sin, mask)
        h = layer_norm(ALPHA * h + mix, ln_g[i, 0], ln_b[i, 0])
        h = layer_norm(ALPHA * h + sq_relu_mlp(h, mlp_w_up[i], mlp_w_down[i]), ln_g[i, 1], ln_b[i, 1])
    return h[:, N_META:]
```

```cpp
#include <hip/hip_runtime.h>
#include <cstdio>
#include <cstdint>

#ifndef MK_N_LAUNCHES
#define MK_N_LAUNCHES 1
#endif

#define LAS __attribute__((address_space(3)))
#define GAS __attribute__((address_space(1)))
typedef unsigned short bf16_t;
typedef short bf16x8 __attribute__((ext_vector_type(8)));
typedef short s16x4 __attribute__((ext_vector_type(4)));
typedef float f32x2 __attribute__((ext_vector_type(2)));
typedef float f32x4 __attribute__((ext_vector_type(4)));
typedef float f32x16 __attribute__((ext_vector_type(16)));
typedef unsigned u32x2 __attribute__((ext_vector_type(2)));
typedef unsigned u32x4 __attribute__((ext_vector_type(4)));

constexpr int D = 1024, NB = 8, SEQ = 4096, NMETA = 16, LTOT = SEQ + NMETA;
constexpr int M = NB * SEQ;
constexpr int MR = M + NMETA;
constexpr int FF = 4096, HD = 64, NH = 16, NKV = 4;
constexpr float LN_EPS = 1e-5f, GN_EPS = 64e-5f;
constexpr float ALPHA = 1.41421356237309515f;
constexpr int N_G1 = 3584;
constexpr int N_L2 = 3072;
constexpr int N_QKV = 1536;

constexpr size_t MiB = 1u << 20;
constexpr size_t WS_CTL = 0, CTL_ZERO_BYTES = 1 * MiB;
constexpr size_t WS_ROPE = 1 * MiB;
constexpr size_t WS_W = 4 * MiB;
constexpr size_t WT_G1 = WS_W;
constexpr size_t WT_L2 = WT_G1 + 7 * MiB;
constexpr size_t WT_O0 = WT_L2 + 3 * MiB / 2;
constexpr size_t WT_UP0 = WT_O0 + 2 * MiB;
constexpr size_t WT_DN0 = WT_UP0 + 8 * MiB;
constexpr size_t WT_QKV = WT_DN0 + 8 * MiB;
constexpr size_t WT_O1 = WT_QKV + 3 * MiB;
constexpr size_t WT_UP1 = WT_O1 + 2 * MiB;
constexpr size_t WT_DN1 = WT_UP1 + 8 * MiB;
constexpr size_t WS_SLOT0 = 52 * MiB, SLOT = 65 * MiB;
constexpr size_t S0 = WS_SLOT0, S1 = S0 + SLOT, S2 = S1 + SLOT, S3 = S2 + SLOT, S4 = S3 + SLOT, S5 = S4 + SLOT, S6 = S5 + SLOT;
constexpr size_t WS_END = S6 + SLOT;
static_assert(WT_DN1 + 8 * MiB <= WS_SLOT0, "weights fit");
static_assert(WS_END <= 512 * MiB, "workspace");
constexpr size_t B_XR = S0, B_XK = S1, B_XV = S2, B_XB = S3;
constexpr size_t B_R = S4, B_K = S5, B_V = S6;
constexpr size_t B_LD = S0;
constexpr size_t B_A = S2, B_G = S3;
constexpr size_t B_RS = S0;
constexpr size_t B_HB = S2;
constexpr size_t B_U = S3;
constexpr size_t B_Q = S3;
constexpr size_t B_KC = S4, B_VC = S4 + 32 * MiB;
constexpr size_t B_AO = S5;
constexpr size_t DO_LP = 0, DO_LA = 40 * MiB, DO_O = 0;

constexpr int CW_BAR = 4096;

__device__ __forceinline__ unsigned f2bf(float f) { unsigned u = __builtin_bit_cast(unsigned, f); return (u + 0x7fffu + ((u >> 16) & 1u)) >> 16; }
__device__ __forceinline__ unsigned pk2(float lo, float hi) { return f2bf(lo) | (f2bf(hi) << 16); }
__device__ __forceinline__ float bf_lo(unsigned w) { return __builtin_bit_cast(float, w << 16); }
__device__ __forceinline__ float bf_hi(unsigned w) { return __builtin_bit_cast(float, w & 0xffff0000u); }
__device__ __forceinline__ u32x4 pack8(f32x4 a, f32x4 b) { u32x4 w; w.x = pk2(a.x, a.y); w.y = pk2(a.z, a.w); w.z = pk2(b.x, b.y); w.w = pk2(b.z, b.w); return w; }
__device__ __forceinline__ void unpack8(u32x4 w, f32x4& a, f32x4& b) { a.x = bf_lo(w.x); a.y = bf_hi(w.x); a.z = bf_lo(w.y); a.w = bf_hi(w.y); b.x = bf_lo(w.z); b.y = bf_hi(w.z); b.z = bf_lo(w.w); b.w = bf_hi(w.w); }
template <int CTRL> __device__ __forceinline__ float dppf(float x) { return __builtin_bit_cast(float, __builtin_amdgcn_update_dpp(0, __builtin_bit_cast(int, x), CTRL, 0xF, 0xF, true)); }
__device__ __forceinline__ float sum8(float x) { x += dppf<0xB1>(x); x += dppf<0x4E>(x); x += dppf<0x141>(x); return x; }
__device__ __forceinline__ float wave_sum(float v) {
#pragma unroll
    for (int o = 1; o < 64; o <<= 1) v += __shfl_xor(v, o);
    return v;
}
__device__ __forceinline__ float sigmoidf_(float z) { return 1.0f / (1.0f + __expf(-z)); }
__device__ __forceinline__ int xb_row(int m) { return (m >> 12) * (SEQ + 1) + (m & (SEQ - 1)) + 1; }

namespace pg8 {
constexpr int BM = 256, BK = 64, HALF = 128, HTB = HALF * BK * 2, STAGE_BYTES = 8 * HTB, NXCD = 8, WGM = 8;
__host__ __device__ __forceinline__ int lds_byte(int r, int c) { const int st = (r >> 4) * 2 + (c >> 5), rr = r & 15, cc = c & 31, ob = rr * 64 + cc * 2; return st * 1024 + (ob ^ (((ob >> 9) & 1) << 5)); }
__host__ __device__ __forceinline__ void stage_rc(int b, int& R, int& C) { const int st = b / 1024, sb = b % 1024, swz = sb ^ (((sb >> 9) & 1) << 5); R = (st >> 1) * 16 + swz / 64; C = (st & 1) * 32 + (swz % 64) / 2; }
__host__ __device__ __forceinline__ int perm32(int rho) { const int n = rho >> 4, i = rho & 15; return 8 * (i >> 2) + 4 * n + (i & 3); }
struct Unit { int pm, pn; };
struct StaticOrder {
    int nM, nN, nwg, G, c;
    __host__ __device__ void init(int M_, int N_, int G_, int c_) { nM = M_ / BM; nN = N_ / BM; nwg = nM * nN; G = G_; c = c_; }
    __host__ __device__ bool next(int i, Unit& u) const {
        const long L = (long)i * G + c; if (L >= nwg) return false;
        int wgid = (int)L; { const int q = nwg / NXCD, r = nwg % NXCD, xcd = wgid % NXCD, off = wgid / NXCD; wgid = (xcd < r ? xcd * (q + 1) : r * (q + 1) + (xcd - r) * q) + off; }
        const int nig = WGM * nN, gid = wgid / nig, fm = gid * WGM, gsz = (nM - fm) < WGM ? (nM - fm) : WGM;
        u.pm = fm + ((wgid % nig) % gsz); u.pn = (wgid % nig) / gsz; return true;
    }
};
template <class F> struct Epi8 {
    F f;
    __device__ __forceinline__ void operator()(const f32x4 (&acc)[2][2][4][2], const Unit& u, int wr, int wc, int fr, int fq) const {
        const int row0 = u.pm * BM + wr * 64 + fr, col0 = u.pn * BM + wc * 32 + 8 * fq;
#pragma unroll
        for (int ai = 0; ai < 2; ++ai)
#pragma unroll
            for (int m = 0; m < 4; ++m)
#pragma unroll
                for (int bj = 0; bj < 2; ++bj) f(row0 + ai * HALF + m * 16, col0 + bj * HALF, acc[ai][bj][m][0], acc[ai][bj][m][1]);
    }
};

template <class Epi, class AMap>
__device__ __forceinline__ void gemm_phase(LAS unsigned char* lds, const AMap AM, const bf16_t* Bt, int K, const StaticOrder& S, const Epi& E) {
    const int tid = threadIdx.x, wid = __builtin_amdgcn_readfirstlane(tid >> 6), lane = tid & 63, wr = wid >> 2, wc = wid & 3, fr = lane & 15, fq = lane >> 4;
    const int nt = K / BK;
    unsigned voffA[2], voffB[2];
#pragma unroll
    for (int i = 0; i < 2; ++i) { int R, C; stage_rc(tid * 16 + i * 8192, R, C); const int Rb = (R & ~31) + perm32(R & 31);
        voffA[i] = (unsigned)(R * K + C) * 2u; voffB[i] = (unsigned)(Rb * K + C) * 2u; }
    const size_t kstep = (size_t)(BK * 2);
    const size_t hstep = (size_t)HALF * K * 2;
    const size_t tstep = 2 * hstep;
    const unsigned ldsw = (unsigned)wid * 1024u;
    const int aoff = lds_byte(wr * 64 + fr, fq * 8), boff = lds_byte(wc * 32 + fr, fq * 8);
#define PG8_SA(b, h) (((b) * 2 + (h)) * HTB)
#define PG8_SB(b, h) ((4 + (b) * 2 + (h)) * HTB)
#define PG8_STAGE(bufoff, gbase, voff) do { _Pragma("unroll") for (int _i = 0; _i < 2; ++_i) \
        __builtin_amdgcn_global_load_lds((const unsigned*)((const char*)(gbase) + (voff)[_i]), (LAS unsigned*)(lds + (bufoff) + ldsw + _i * 8192), 16, 0, 0); } while (0)
#define PG8_LDA(dst, b, h) do { _Pragma("unroll") for (int m = 0; m < 4; ++m) _Pragma("unroll") for (int k = 0; k < 2; ++k) dst[m][k] = *(const LAS bf16x8*)(lds + PG8_SA(b, h) + aoff + m * 2048 + k * 1024); } while (0)
#define PG8_LDB(dst, b, h) do { _Pragma("unroll") for (int n = 0; n < 2; ++n) _Pragma("unroll") for (int k = 0; k < 2; ++k) dst[n][k] = *(const LAS bf16x8*)(lds + PG8_SB(b, h) + boff + n * 2048 + k * 1024); } while (0)
#define PG8_MMA(ai, bj, At, Bt_) do { __builtin_amdgcn_s_setprio(1); _Pragma("unroll") for (int m = 0; m < 4; ++m) _Pragma("unroll") for (int n = 0; n < 2; ++n) _Pragma("unroll") for (int k = 0; k < 2; ++k) \
        acc[ai][bj][m][n] = __builtin_amdgcn_mfma_f32_16x16x32_bf16(Bt_[n][k], At[m][k], acc[ai][bj][m][n], 0, 0, 0); __builtin_amdgcn_s_setprio(0); } while (0)
#define PG8_WAIT_V(n) asm volatile("s_waitcnt vmcnt(" #n ")" ::: "memory")
#define PG8_WAIT_L(n) asm volatile("s_waitcnt lgkmcnt(" #n ")" ::: "memory")
#define PG8_BAR __builtin_amdgcn_s_barrier()
#define PG8_SCHED __builtin_amdgcn_sched_barrier(0)
    Unit cur, nxt; int ui = 0;
    if (!S.next(0, cur)) return;
    f32x4 acc[2][2][4][2];
#pragma unroll
    for (int a = 0; a < 2; ++a)
#pragma unroll
        for (int b = 0; b < 2; ++b)
#pragma unroll
            for (int m = 0; m < 4; ++m)
#pragma unroll
                for (int n = 0; n < 2; ++n) acc[a][b][m][n] = (f32x4){0.f, 0.f, 0.f, 0.f};
    bf16x8 At[4][2], B0[2][2], B1[2][2];
    const char* cA = AM.tile(cur.pm, cur.pn); const char* cB = (const char*)Bt + (size_t)cur.pn * tstep;
    PG8_STAGE(PG8_SB(0, 0), cB, voffB); PG8_STAGE(PG8_SB(0, 1), cB + hstep, voffB); PG8_STAGE(PG8_SA(0, 0), cA, voffA); PG8_STAGE(PG8_SA(0, 1), cA + hstep, voffA);
    if (wr == 1) PG8_BAR;
    PG8_WAIT_V(2); PG8_BAR;
    PG8_STAGE(PG8_SB(1, 0), cB + kstep, voffB); PG8_STAGE(PG8_SA(1, 0), cA + kstep, voffA); PG8_STAGE(PG8_SB(1, 1), cB + hstep + kstep, voffB);
    PG8_WAIT_V(6); PG8_BAR;
    for (;;) {
        const bool has_next = S.next(ui + 1, nxt);
        const char* nA = has_next ? AM.tile(nxt.pm, nxt.pn) : cA; const char* nB = has_next ? (const char*)Bt + (size_t)nxt.pn * tstep : cB;
        for (int t = 0; t < nt; t += 2) {
            const bool last = (t == nt - 2);
            const char* a1 = cA + (size_t)(t + 1) * kstep;
            const char* a2 = last ? nA : cA + (size_t)(t + 2) * kstep; const char* b2 = last ? nB : cB + (size_t)(t + 2) * kstep;
            const char* a3 = a2 + kstep; const char* b3 = b2 + kstep;
            PG8_LDB(B0, 0, 0); PG8_LDB(B1, 0, 1); PG8_SCHED; PG8_LDA(At, 0, 0); PG8_STAGE(PG8_SA(1, 1), a1 + hstep, voffA);
            PG8_WAIT_V(8); PG8_WAIT_L(0); PG8_BAR; PG8_MMA(0, 0, At, B0); PG8_MMA(0, 1, At, B1); PG8_BAR; PG8_SCHED;
            PG8_LDA(At, 0, 1); PG8_STAGE(PG8_SB(0, 0), b2, voffB); PG8_STAGE(PG8_SB(0, 1), b2 + hstep, voffB); PG8_STAGE(PG8_SA(0, 0), a2, voffA);
            PG8_WAIT_V(8); PG8_WAIT_L(0); PG8_BAR; PG8_MMA(1, 0, At, B0); PG8_MMA(1, 1, At, B1); PG8_BAR; PG8_SCHED;
            PG8_LDB(B0, 1, 0); PG8_LDB(B1, 1, 1); PG8_SCHED; PG8_LDA(At, 1, 0); PG8_STAGE(PG8_SA(0, 1), a2 + hstep, voffA);
            PG8_WAIT_V(8); PG8_WAIT_L(0); PG8_BAR; PG8_MMA(0, 0, At, B0); PG8_MMA(0, 1, At, B1); PG8_BAR; PG8_SCHED;
            PG8_LDA(At, 1, 1); PG8_STAGE(PG8_SB(1, 0), b3, voffB); PG8_STAGE(PG8_SB(1, 1), b3 + hstep, voffB); PG8_STAGE(PG8_SA(1, 0), a3, voffA);
            PG8_WAIT_V(8); PG8_WAIT_L(0); PG8_BAR; PG8_MMA(1, 0, At, B0); PG8_MMA(1, 1, At, B1); PG8_BAR; PG8_SCHED;
        }
        if (wr == 0) PG8_BAR;
        E(acc, cur, wr, wc, fr, fq);
        if (!has_next) break;
#pragma unroll
        for (int a = 0; a < 2; ++a)
#pragma unroll
            for (int b = 0; b < 2; ++b)
#pragma unroll
                for (int m = 0; m < 4; ++m)
#pragma unroll
                    for (int n = 0; n < 2; ++n) acc[a][b][m][n] = (f32x4){0.f, 0.f, 0.f, 0.f};
        cur = nxt; cA = nA; cB = nB; ++ui;
        if (wr == 1) PG8_BAR;
    }
    PG8_WAIT_V(0);
    PG8_BAR;
#undef PG8_SA
#undef PG8_SB
#undef PG8_STAGE
#undef PG8_LDA
#undef PG8_LDB
#undef PG8_MMA
#undef PG8_WAIT_V
#undef PG8_WAIT_L
#undef PG8_BAR
#undef PG8_SCHED
}
}

#define XB_TMO      128
#define XB_XCNT(j)  (256  + 64 * (j))
#define XB_XSUB(j)  (1280 + 64 * (j))
#define XB_XGEN(j)  (2304 + 64 * (j))
#define XB_TOP      3328
#define XB_TOPGEN   3392
#define XCD_BAR_WORDS 3456
#define XB_SPIN_CAP (1u << 18)
__device__ __forceinline__ unsigned xb_ld(unsigned* p)              { return __hip_atomic_load(p, __ATOMIC_RELAXED, __HIP_MEMORY_SCOPE_AGENT); }
__device__ __forceinline__ unsigned xb_add(unsigned* p, unsigned v) { return __hip_atomic_fetch_add(p, v, __ATOMIC_RELAXED, __HIP_MEMORY_SCOPE_AGENT); }
__device__ __forceinline__ unsigned xb_xcc_id() { return (unsigned)__builtin_amdgcn_s_getreg((3 << 11) | 20) & 0xFu; }
#define XB_SPIN(cond, bar) do { unsigned _sp = 0; while (cond) { __builtin_amdgcn_s_sleep(1); \
    if ((++_sp & 255u) == 0u) { if (xb_ld(&(bar)[XB_TMO])) break; if (_sp > XB_SPIN_CAP) { atomicAdd(&(bar)[XB_TMO], 1u); break; } } } } while (0)
struct XcdBarrier { unsigned* bar; unsigned x; volatile LAS unsigned* st; };
__device__ __forceinline__ XcdBarrier xcd_barrier_post(unsigned* bar, volatile LAS unsigned* st) {
    XcdBarrier b; b.bar = bar; b.x = xb_xcc_id(); b.st = st;
    if (threadIdx.x == 0) (void)xb_add(&bar[XB_XCNT(b.x)], 1u);
    return b;
}
__device__ __forceinline__ void xcd_barrier_complete(unsigned* bar, unsigned x, unsigned& nloc, unsigned& nx) {
    const unsigned G = gridDim.x * gridDim.y * gridDim.z;
    unsigned sum, cnt, mine, sp = 0u;
    for (;;) {
        sum = 0u; cnt = 0u; mine = 0u;
#pragma unroll
        for (unsigned j = 0; j < 16; ++j) { const unsigned c = xb_ld(&bar[XB_XCNT(j)]); sum += c; cnt += (c > 0u) ? 1u : 0u; mine = (j == x) ? c : mine; }
        if (sum == G) break;
        __builtin_amdgcn_s_sleep(1);
        if ((++sp & 255u) == 0u) { if (xb_ld(&bar[XB_TMO])) break; if (sp > XB_SPIN_CAP) { atomicAdd(&bar[XB_TMO], 1u); break; } }
    }
    nloc = mine > 0u ? mine : 1u; nx = cnt > 0u ? cnt : 1u;
}
__device__ __forceinline__ void xcd_barrier(const XcdBarrier& b) {
    asm volatile("s_waitcnt vmcnt(0)" ::: "memory");
    __syncthreads();
    if (threadIdx.x == 0) {
        unsigned* bar = b.bar;
        __builtin_amdgcn_s_waitcnt(0);
        unsigned nloc = b.st[0], nx = b.st[1];
        if (nloc == 0u) { xcd_barrier_complete(bar, b.x, nloc, nx); b.st[0] = nloc; b.st[1] = nx; }
        const unsigned old = xb_add(&bar[XB_XSUB(b.x)], 1u);
        const unsigned gen = old / nloc;
        if (old + 1u == (gen + 1u) * nloc) {
            __builtin_amdgcn_fence(__ATOMIC_RELEASE, "agent");
            asm volatile("s_waitcnt vmcnt(0)" ::: "memory");
            const unsigned og = xb_add(&bar[XB_TOP], 1u);
            const unsigned tg = og / nx;
            if (og + 1u == (tg + 1u) * nx) xb_add(&bar[XB_TOPGEN], 1u);
            else XB_SPIN(xb_ld(&bar[XB_TOPGEN]) == tg, bar);
            __builtin_amdgcn_fence(__ATOMIC_ACQUIRE, "agent");
            xb_add(&bar[XB_XGEN(b.x)], 1u);
            asm volatile("s_waitcnt vmcnt(0)" ::: "memory");
        } else {
            XB_SPIN(xb_ld(&bar[XB_XGEN(b.x)]) == gen, bar);
            __builtin_amdgcn_fence(__ATOMIC_ACQUIRE, "agent");
            asm volatile("s_waitcnt vmcnt(0)" ::: "memory");
        }
    }
    __syncthreads();
}

constexpr int RING_BYTES = 131072;
constexpr int LDSCTL_OFF = RING_BYTES, MISC_OFF = LDSCTL_OFF + 320;
constexpr int LDS_BYTES = 147456;
constexpr int NWAVES = 8, NTHREADS = 512;

struct Args { const float* in[29]; float* out; unsigned char* ws; int ph_lo, ph_hi; };
enum { I_X = 0, I_META, I_MU, I_WR, I_WK, I_WV, I_WO, I_W0, I_W1, I_W2, I_A0, I_A1, I_A2, I_G1, I_G2, I_KK, I_KA, I_RK, I_GNW, I_GNB,
       I_KVK, I_KVV, I_WQ, I_SINK, I_BWO, I_UP, I_DN, I_LNG, I_LNB };

struct AMapPlain {
    const char* A; size_t tile_bytes;
    __device__ __forceinline__ const char* tile(int pm, int) const { return A + (size_t)pm * tile_bytes; }
    __device__ __forceinline__ const char* row(int m, int, int K) const { return A + (size_t)m * K * 2; }
};
struct AMapG1 {
    const char* ws;
    __device__ __forceinline__ const char* row(int m, int pn, int) const {
        if (pn < 12) return ws + (pn < 4 ? B_XR : (pn < 8 ? B_XK : B_XV)) + (size_t)m * (D * 2);
        return ws + B_XB + (size_t)(xb_row(m) - (pn == 13 ? 1 : 0)) * (D * 2);
    }
    __device__ __forceinline__ const char* tile(int pm, int pn) const { return row(pm * 256, pn, D); }
};

template <class AMap, class F>
__device__ __forceinline__ void meta_gemm(LAS unsigned char* lds, const AMap AM, const bf16_t* Bt, int N, int K, int vcu, int G, const F& f, int cg_lo = 0, int cg_hi = -1) {
    const int tid = threadIdx.x, wid = __builtin_amdgcn_readfirstlane(tid >> 6), lane = tid & 63, tok = lane & 15, fq = lane >> 4;
    if (cg_hi < 0) cg_hi = N / 32;
    const int kw = K / 8;
    LAS f32x4* red = (LAS f32x4*)lds;
    for (int cg = cg_lo + vcu; cg < cg_hi; cg += G) {
        const int n0 = cg * 32, pn = n0 >> 8;
        const bf16_t* xrow = (const bf16_t*)AM.row(M + tok, pn, K) + wid * kw + 8 * fq;
        const bf16_t* w0 = Bt + (size_t)(n0 + 8 * (tok >> 2) + (tok & 3)) * K + wid * kw + 8 * fq;
        const bf16_t* w1 = w0 + (size_t)4 * K;
        f32x4 c0 = {0.f, 0.f, 0.f, 0.f}, c1 = {0.f, 0.f, 0.f, 0.f};
#pragma unroll 4
        for (int k = 0; k < kw; k += 32) {
            const bf16x8 xa = *(const bf16x8*)(xrow + k), wa = *(const bf16x8*)(w0 + k), wb = *(const bf16x8*)(w1 + k);
            c0 = __builtin_amdgcn_mfma_f32_16x16x32_bf16(wa, xa, c0, 0, 0, 0);
            c1 = __builtin_amdgcn_mfma_f32_16x16x32_bf16(wb, xa, c1, 0, 0, 0);
        }
        red[(wid * 64 + lane) * 2] = c0; red[(wid * 64 + lane) * 2 + 1] = c1;
        __syncthreads();
        if (wid == 0) {
            f32x4 s0 = red[lane * 2], s1 = red[lane * 2 + 1];
#pragma unroll
            for (int w = 1; w < 8; ++w) { s0 += red[(w * 64 + lane) * 2]; s1 += red[(w * 64 + lane) * 2 + 1]; }
            f(M + tok, n0 + 8 * fq, s0, s1);
        }
        __syncthreads();
    }
}

struct EpiG1 {
    unsigned char* ws; unsigned char* dout;
    __device__ __forceinline__ void operator()(int m, int c, f32x4 lo, f32x4 hi) const {
        bf16_t* p;
        if (c < 3072) p = (bf16_t*)(ws + (c < 1024 ? B_R : (c < 2048 ? B_K : B_V))) + (size_t)m * D + (c & 1023);
        else p = (bf16_t*)(dout + DO_LP) + (size_t)m * 512 + (c - 3072);
        *(u32x4*)p = pack8(lo, hi);
    }
};
struct EpiL2 {
    unsigned char* ws; const float* w0; const float* a0;
    __device__ __forceinline__ void operator()(int m, int c, f32x4 lo, f32x4 hi) const {
        if (c < 1024) {
            const f32x4 b0 = *(const f32x4*)(w0 + c), b1 = *(const f32x4*)(w0 + c + 4);
            f32x4 o0, o1;
#pragma unroll
            for (int i = 0; i < 4; ++i) { o0[i] = -0.60653065971263342f * sigmoidf_(b0[i] + lo[i]); o1[i] = -0.60653065971263342f * sigmoidf_(b1[i] + hi[i]); }
            float* p = (float*)(ws + B_LD) + (size_t)m * D + c; *(f32x4*)p = o0; *(f32x4*)(p + 4) = o1;
        } else if (c < 2048) {
            const int cc = c - 1024; const f32x4 b0 = *(const f32x4*)(a0 + cc), b1 = *(const f32x4*)(a0 + cc + 4);
            f32x4 o0, o1;
#pragma unroll
            for (int i = 0; i < 4; ++i) { o0[i] = sigmoidf_(b0[i] + lo[i]); o1[i] = sigmoidf_(b1[i] + hi[i]); }
            *(u32x4*)((bf16_t*)(ws + B_A) + (size_t)m * D + cc) = pack8(o0, o1);
        } else {
            *(u32x4*)((bf16_t*)(ws + B_G) + (size_t)m * D + (c - 2048)) = pack8(lo, hi);
        }
    }
};
struct EpiRes {
    unsigned char* ws; const float* x; const float* meta;
    __device__ __forceinline__ void operator()(int m, int c, f32x4 lo, f32x4 hi) const {
        float* p = (float*)(ws + B_RS) + (size_t)m * D + c;
        const float* b = x ? (m < M ? x + (size_t)m * D + c : meta + (size_t)(m - M) * D + c) : p;
        const f32x4 b0 = *(const f32x4*)b, b1 = *(const f32x4*)(b + 4);
        *(f32x4*)p = b0 * ALPHA + lo; *(f32x4*)(p + 4) = b1 * ALPHA + hi;
    }
};
struct EpiUp {
    unsigned char* ws;
    __device__ __forceinline__ void operator()(int m, int c, f32x4 lo, f32x4 hi) const {
#pragma unroll
        for (int i = 0; i < 4; ++i) { const float a = fmaxf(lo[i], 0.f), b = fmaxf(hi[i], 0.f); lo[i] = a * a; hi[i] = b * b; }
        *(u32x4*)((bf16_t*)(ws + B_U) + (size_t)m * FF + c) = pack8(lo, hi);
    }
};
struct EpiQKV {
    unsigned char* ws;
    __device__ __forceinline__ void operator()(int m, int c, f32x4 lo, f32x4 hi) const {
        const int pos = m < M ? (m & (SEQ - 1)) + NMETA : m - M;
        if (c < 1280) {
            const int d0 = 4 * ((c & 63) >> 3);
            const float* ct = (const float*)(ws + WS_ROPE) + (size_t)pos * 32 + d0;
            const f32x4 cs = *(const f32x4*)ct, sn = *(const f32x4*)(ct + LTOT * 32);
            f32x4 o1 = lo * cs - hi * sn, o2 = hi * cs + lo * sn;
            if (c < 1024) { if (m >= M) return; o1 *= 0.125f; o2 *= 0.125f; *(u32x4*)((bf16_t*)(ws + B_Q) + (size_t)m * D + c) = pack8(o1, o2); return; }
            lo = o1; hi = o2;
        }
        bf16_t* base = (bf16_t*)(ws + (c < 1280 ? B_KC : B_VC)); const int cc = c < 1280 ? c - 1024 : c - 1280;
        const u32x4 w = pack8(lo, hi);
        if (m < M) { *(u32x4*)(base + (size_t)((m >> 12) * LTOT + pos) * 256 + cc) = w; }
        else {
#pragma unroll
            for (int b = 0; b < NB; ++b) *(u32x4*)(base + (size_t)(b * LTOT + pos) * 256 + cc) = w;
        }
    }
};

struct Frame {
    LAS unsigned char* lds;
    int tid, lane, wave, vcu, G;
    unsigned char* ws; unsigned char* dout;
};

struct WDesc { const float* W; int ldw; int Ksrc; int Nsrc; bf16_t* dst; int ldd; int row_off; int k_off; const float* mu; int mode; int perm; };
__device__ __forceinline__ int rope_src_col(int n) { const int j = n & 63; return (n & ~63) + ((j & 4) ? 32 : 0) + 4 * (j >> 3) + (j & 3); }
__device__ __forceinline__ void p0_transpose_item(const WDesc& d, LAS float* scr, int item, int lane) {
    const int nblk = d.Nsrc / 32, kb = item / nblk, nb = item % nblk, k0 = 64 * kb, n0 = 32 * nb;
    const int nn = n0 + (lane & 31), sc = d.perm ? rope_src_col(nn) : nn;
#pragma unroll 8
    for (int i = 0; i < 32; ++i) { const int kk = 2 * i + (lane >> 5); float v = d.W[(size_t)(k0 + kk) * d.ldw + sc];
        if (d.mode) { const float mu = d.mu[k0 + kk]; v *= (d.mode == 1 ? 1.0f - mu : mu); }
        scr[kk * 33 + (lane & 31)] = v; }
    asm volatile("s_waitcnt lgkmcnt(0)" ::: "memory");
    const int c = lane & 7;
#pragma unroll
    for (int j = 0; j < 4; ++j) { const int n = (lane >> 3) + 8 * j; const LAS float* s = scr + (8 * c) * 33 + n;
        u32x4 o; o.x = pk2(s[0 * 33], s[1 * 33]); o.y = pk2(s[2 * 33], s[3 * 33]); o.z = pk2(s[4 * 33], s[5 * 33]); o.w = pk2(s[6 * 33], s[7 * 33]);
        *(u32x4*)(d.dst + (size_t)(d.row_off + n0 + n) * d.ldd + d.k_off + k0 + 8 * c) = o; }
    asm volatile("s_waitcnt lgkmcnt(0)" ::: "memory");
}
constexpr int NWD = 21;
__device__ __forceinline__ WDesc wdesc(const Args& a, int id) {
    unsigned char* ws = a.ws; WDesc d; d.mu = nullptr; d.mode = 0; d.perm = 0; d.k_off = 0; d.row_off = 0;
    const float* mu = a.in[I_MU];
    switch (id) {
    case 0:  d.W = a.in[I_WR]; d.ldw = D; d.Ksrc = D; d.Nsrc = D; d.dst = (bf16_t*)(ws + WT_G1); d.ldd = D; d.row_off = 0; break;
    case 1:  d.W = a.in[I_WK]; d.ldw = D; d.Ksrc = D; d.Nsrc = D; d.dst = (bf16_t*)(ws + WT_G1); d.ldd = D; d.row_off = 1024; break;
    case 2:  d.W = a.in[I_WV]; d.ldw = D; d.Ksrc = D; d.Nsrc = D; d.dst = (bf16_t*)(ws + WT_G1); d.ldd = D; d.row_off = 2048; break;
    case 3:  d.W = a.in[I_W1]; d.ldw = 64; d.Ksrc = D; d.Nsrc = 64; d.dst = (bf16_t*)(ws + WT_G1); d.ldd = D; d.row_off = 3072; d.mu = mu + 1 * D; d.mode = 1; break;
    case 4:  d.W = a.in[I_A1]; d.ldw = 64; d.Ksrc = D; d.Nsrc = 64; d.dst = (bf16_t*)(ws + WT_G1); d.ldd = D; d.row_off = 3136; d.mu = mu + 4 * D; d.mode = 1; break;
    case 5:  d.W = a.in[I_G1]; d.ldw = 128; d.Ksrc = D; d.Nsrc = 128; d.dst = (bf16_t*)(ws + WT_G1); d.ldd = D; d.row_off = 3200; d.mu = mu + 5 * D; d.mode = 1; break;
    case 6:  d.W = a.in[I_W1]; d.ldw = 64; d.Ksrc = D; d.Nsrc = 64; d.dst = (bf16_t*)(ws + WT_G1); d.ldd = D; d.row_off = 3328; d.mu = mu + 1 * D; d.mode = 2; break;
    case 7:  d.W = a.in[I_A1]; d.ldw = 64; d.Ksrc = D; d.Nsrc = 64; d.dst = (bf16_t*)(ws + WT_G1); d.ldd = D; d.row_off = 3392; d.mu = mu + 4 * D; d.mode = 2; break;
    case 8:  d.W = a.in[I_G1]; d.ldw = 128; d.Ksrc = D; d.Nsrc = 128; d.dst = (bf16_t*)(ws + WT_G1); d.ldd = D; d.row_off = 3456; d.mu = mu + 5 * D; d.mode = 2; break;
    case 9:  d.W = a.in[I_WO]; d.ldw = D; d.Ksrc = D; d.Nsrc = D; d.dst = (bf16_t*)(ws + WT_O0); d.ldd = D; break;
    case 10: d.W = a.in[I_UP]; d.ldw = FF; d.Ksrc = D; d.Nsrc = FF; d.dst = (bf16_t*)(ws + WT_UP0); d.ldd = D; break;
    case 11: d.W = a.in[I_DN]; d.ldw = D; d.Ksrc = FF; d.Nsrc = D; d.dst = (bf16_t*)(ws + WT_DN0); d.ldd = FF; break;
    case 12: d.W = a.in[I_WQ]; d.ldw = D; d.Ksrc = D; d.Nsrc = D; d.dst = (bf16_t*)(ws + WT_QKV); d.ldd = D; d.row_off = 0; d.perm = 1; break;
    case 13: d.W = a.in[I_KVK]; d.ldw = 256; d.Ksrc = D; d.Nsrc = 256; d.dst = (bf16_t*)(ws + WT_QKV); d.ldd = D; d.row_off = 1024; d.perm = 1; break;
    case 14: d.W = a.in[I_KVV]; d.ldw = 256; d.Ksrc = D; d.Nsrc = 256; d.dst = (bf16_t*)(ws + WT_QKV); d.ldd = D; d.row_off = 1280; break;
    case 15: d.W = a.in[I_BWO]; d.ldw = D; d.Ksrc = D; d.Nsrc = D; d.dst = (bf16_t*)(ws + WT_O1); d.ldd = D; break;
    case 16: d.W = a.in[I_UP] + (size_t)D * FF; d.ldw = FF; d.Ksrc = D; d.Nsrc = FF; d.dst = (bf16_t*)(ws + WT_UP1); d.ldd = D; break;
    case 17: d.W = a.in[I_DN] + (size_t)D * FF; d.ldw = D; d.Ksrc = FF; d.Nsrc = D; d.dst = (bf16_t*)(ws + WT_DN1); d.ldd = FF; break;
    case 18: d.W = a.in[I_W2]; d.ldw = D; d.Ksrc = 64; d.Nsrc = D; d.dst = (bf16_t*)(ws + WT_L2); d.ldd = 256; d.row_off = 0; d.k_off = 0; break;
    case 19: d.W = a.in[I_A2]; d.ldw = D; d.Ksrc = 64; d.Nsrc = D; d.dst = (bf16_t*)(ws + WT_L2); d.ldd = 256; d.row_off = 1024; d.k_off = 64; break;
    default: d.W = a.in[I_G2]; d.ldw = D; d.Ksrc = 128; d.Nsrc = D; d.dst = (bf16_t*)(ws + WT_L2); d.ldd = 256; d.row_off = 2048; d.k_off = 128; break;
    }
    return d;
}
__device__ __forceinline__ void p0_prologue(const Frame& F, const Args& a) {
    const int gw = F.vcu * NWAVES + F.wave, NGW = F.G * NWAVES, lane = F.lane;
    unsigned char* ws = F.ws;
    {
        u32x4* z = (u32x4*)(ws + WT_L2); const int nvec = N_L2 * 256 * 2 / 16;
        for (int i = gw * 64 + lane; i < nvec; i += NGW * 64) { const int row = i >> 5, k = (i & 31) * 8; const int blk = row >> 10;
            const bool nz = (blk == 0 && k < 64) || (blk == 1 && k >= 64 && k < 128) || (blk == 2 && k >= 128);
            if (!nz) z[i] = (u32x4){0u, 0u, 0u, 0u}; }
    }
    {
        LAS float* scr = (LAS float*)(F.lds + F.wave * 16384);
        int base = 0;
        for (int id = 0; id < NWD; ++id) {
            const WDesc d = wdesc(a, id);
            const int nit = (d.Ksrc / 64) * (d.Nsrc / 32);
            int first = (gw - base % NGW + NGW) % NGW;
            for (int it = first; it < nit; it += NGW) p0_transpose_item(d, scr, it, lane);
            base += nit;
        }
    }
    {
        float* ct = (float*)(ws + WS_ROPE);
        for (int i = gw * 64 + lane; i < LTOT * 32; i += NGW * 64) { const int p = i >> 5, j = i & 31;
            const float inv = 1.0f / powf(10000.0f, (float)j * (1.0f / 32.0f)); const float ang = (float)p * inv;
            ct[i] = cosf(ang); ct[LTOT * 32 + i] = sinf(ang); }
    }
    {
        const float* x = a.in[I_X]; const float* meta = a.in[I_META]; const float* mu = a.in[I_MU];
        for (int m = gw; m < MR; m += NGW) {
            const float* xr_ = m < M ? x + (size_t)m * D : meta + (size_t)(m - M) * D;
            const float* xp_ = m < M ? ((m & (SEQ - 1)) ? xr_ - D : meta + 15 * D) : (m > M ? xr_ - D : nullptr);
            const int xbr = xb_row(m);
#pragma unroll
            for (int j = 0; j < 4; ++j) {
                const int c = 4 * lane + 256 * j;
                const f32x4 xv = *(const f32x4*)(xr_ + c); const f32x4 pv = xp_ ? *(const f32x4*)(xp_ + c) : (f32x4){0.f, 0.f, 0.f, 0.f};
                const f32x4 dd = pv - xv;
                const f32x4 m0 = *(const f32x4*)(mu + 0 * D + c), m2 = *(const f32x4*)(mu + 2 * D + c), m3 = *(const f32x4*)(mu + 3 * D + c);
                const f32x4 r = xv + dd * m0, k = xv + dd * m2, v = xv + dd * m3;
                *(u32x2*)((bf16_t*)(ws + B_XR) + (size_t)m * D + c) = (u32x2){pk2(r.x, r.y), pk2(r.z, r.w)};
                *(u32x2*)((bf16_t*)(ws + B_XK) + (size_t)m * D + c) = (u32x2){pk2(k.x, k.y), pk2(k.z, k.w)};
                *(u32x2*)((bf16_t*)(ws + B_XV) + (size_t)m * D + c) = (u32x2){pk2(v.x, v.y), pk2(v.z, v.w)};
                *(u32x2*)((bf16_t*)(ws + B_XB) + (size_t)xbr * D + c) = (u32x2){pk2(xv.x, xv.y), pk2(xv.z, xv.w)};
                if ((m & (SEQ - 1)) == 0) *(u32x2*)((bf16_t*)(ws + B_XB) + (size_t)(xbr - 1) * D + c) = (u32x2){pk2(pv.x, pv.y), pk2(pv.z, pv.w)};
            }
        }
    }
}

__device__ __forceinline__ void lora_combine(const Frame& F) {
    const bf16_t* lp = (const bf16_t*)(F.dout + DO_LP); bf16_t* la = (bf16_t*)(F.dout + DO_LA);
    const int nvec = MR * 32;
    for (int i = (F.vcu * NTHREADS + F.tid); i < nvec; i += F.G * NTHREADS) {
        const int m = i >> 5, c = (i & 31) * 8;
        f32x4 a0, a1, b0, b1; unpack8(*(const u32x4*)(lp + (size_t)m * 512 + c), a0, a1); unpack8(*(const u32x4*)(lp + (size_t)m * 512 + 256 + c), b0, b1);
        a0 += b0; a1 += b1;
        if (c < 64) {
#pragma unroll
            for (int j = 0; j < 4; ++j) { a0[j] = tanhf(a0[j]); a1[j] = tanhf(a1[j]); }
        } else if (c >= 128) {
#pragma unroll
            for (int j = 0; j < 4; ++j) { a0[j] = sigmoidf_(a0[j]); a1[j] = sigmoidf_(a1[j]); }
        }
        *(u32x4*)(la + (size_t)m * 256 + c) = pack8(a0, a1);
    }
}

__device__ __forceinline__ void ln_phase(const Frame& F, const float* g, const float* b, float* final_out) {
    const int gw = F.vcu * NWAVES + F.wave, NGW = F.G * NWAVES, lane = F.lane;
    const int nrows = final_out ? M : MR;
    for (int m = gw; m < nrows; m += NGW) {
        float* row = (float*)(F.ws + B_RS) + (size_t)m * D;
        f32x4 v[4]; float s = 0.f;
#pragma unroll
        for (int j = 0; j < 4; ++j) { v[j] = *(const f32x4*)(row + 4 * lane + 256 * j); s += (v[j].x + v[j].y) + (v[j].z + v[j].w); }
        const float mean = wave_sum(s) * (1.f / D); float s2 = 0.f;
#pragma unroll
        for (int j = 0; j < 4; ++j) { v[j] = v[j] - mean; s2 += (v[j].x * v[j].x + v[j].y * v[j].y) + (v[j].z * v[j].z + v[j].w * v[j].w); }
        const float rstd = 1.f / sqrtf(wave_sum(s2) * (1.f / D) + LN_EPS);
#pragma unroll
        for (int j = 0; j < 4; ++j) {
            const int c = 4 * lane + 256 * j;
            const f32x4 o = v[j] * rstd * *(const f32x4*)(g + c) + *(const f32x4*)(b + c);
            if (final_out) *(f32x4*)(final_out + (size_t)m * D + c) = o;
            else { *(f32x4*)(row + c) = o; *(u32x2*)((bf16_t*)(F.ws + B_HB) + (size_t)m * D + c) = (u32x2){pk2(o.x, o.y), pk2(o.z, o.w)}; }
        }
    }
}

__device__ __forceinline__ void scan_phase(const Frame& F, const Args& a) {
    if (F.vcu >= NB * NH) return;
    const int b = F.vcu >> 4, h = F.vcu & 15, tid = F.tid;
    LAS float* sR = (LAS float*)F.lds; LAS float* sW = sR + 4096; LAS float* sK = sW + 4096; LAS float* sV = sK + 4096;
    LAS float* sA = sV + 4096; LAS float* sB = sA + 4096; LAS float* sG = sB + 4096; LAS float* sY = sG + 4096;
    const bf16_t* Rg = (const bf16_t*)(F.ws + B_R); const bf16_t* Kg = (const bf16_t*)(F.ws + B_K); const bf16_t* Vg = (const bf16_t*)(F.ws + B_V);
    const bf16_t* Ag = (const bf16_t*)(F.ws + B_A); const bf16_t* Gg = (const bf16_t*)(F.ws + B_G); const float* LDg = (const float*)(F.ws + B_LD);
    bf16_t* Og = (bf16_t*)(F.dout + DO_O);
    const int tt = tid >> 3, j0 = (tid & 7) * 8, hc = h * 64 + j0;
    const int si = tid >> 3, sq = tid & 7;
    f32x4 kk0 = *(const f32x4*)(a.in[I_KK] + hc), kk1 = *(const f32x4*)(a.in[I_KK] + hc + 4);
    f32x4 ka0 = *(const f32x4*)(a.in[I_KA] + hc), ka1 = *(const f32x4*)(a.in[I_KA] + hc + 4);
    f32x4 rk0 = *(const f32x4*)(a.in[I_RK] + hc), rk1 = *(const f32x4*)(a.in[I_RK] + hc + 4);
    f32x4 gw0 = *(const f32x4*)(a.in[I_GNW] + hc), gw1 = *(const f32x4*)(a.in[I_GNW] + hc + 4);
    f32x4 gb0 = *(const f32x4*)(a.in[I_GNB] + hc), gb1 = *(const f32x4*)(a.in[I_GNB] + hc + 4);
    f32x4 st0 = {0.f, 0.f, 0.f, 0.f}, st1 = {0.f, 0.f, 0.f, 0.f};
    for (int ch = -1; ch < SEQ / 64; ++ch) {
        const int ntok = ch < 0 ? NMETA : 64;
        const int m = ch < 0 ? M + tt : b * SEQ + ch * 64 + tt;
        if (tt < ntok) {
            const size_t o = (size_t)m * D + hc;
            f32x4 r0, r1, k0, k1, v0, v1, a0, a1, g0, g1;
            unpack8(*(const u32x4*)(Rg + o), r0, r1); unpack8(*(const u32x4*)(Kg + o), k0, k1); unpack8(*(const u32x4*)(Vg + o), v0, v1);
            unpack8(*(const u32x4*)(Ag + o), a0, a1); unpack8(*(const u32x4*)(Gg + o), g0, g1);
            const f32x4 l0 = *(const f32x4*)(LDg + o), l1 = *(const f32x4*)(LDg + o + 4);
            f32x4 q0 = k0 * kk0, q1 = k1 * kk1;
            float ss = (q0.x * q0.x + q0.y * q0.y) + (q0.z * q0.z + q0.w * q0.w) + (q1.x * q1.x + q1.y * q1.y) + (q1.z * q1.z + q1.w * q1.w);
            ss = sum8(ss);
            const float inv = 1.0f / fmaxf(sqrtf(ss), 1e-12f);
            q0 *= inv; q1 *= inv;
            const f32x4 km0 = k0 * (1.0f + (a0 - 1.0f) * ka0), km1 = k1 * (1.0f + (a1 - 1.0f) * ka1);
            f32x4 w0, w1;
#pragma unroll
            for (int i = 0; i < 4; ++i) { w0[i] = __expf(l0[i]); w1[i] = __expf(l1[i]); }
            const int lo_ = tt * 64 + j0;
            *(LAS f32x4*)(sR + lo_) = r0; *(LAS f32x4*)(sR + lo_ + 4) = r1;
            *(LAS f32x4*)(sW + lo_) = w0; *(LAS f32x4*)(sW + lo_ + 4) = w1;
            *(LAS f32x4*)(sK + lo_) = km0; *(LAS f32x4*)(sK + lo_ + 4) = km1;
            *(LAS f32x4*)(sV + lo_) = v0; *(LAS f32x4*)(sV + lo_ + 4) = v1;
            *(LAS f32x4*)(sA + lo_) = -q0; *(LAS f32x4*)(sA + lo_ + 4) = -q1;
            *(LAS f32x4*)(sB + lo_) = q0 * a0; *(LAS f32x4*)(sB + lo_ + 4) = q1 * a1;
            *(LAS f32x4*)(sG + lo_) = g0; *(LAS f32x4*)(sG + lo_ + 4) = g1;
        }
        __syncthreads();
#pragma unroll 2
        for (int t = 0; t < ntok; ++t) {
            const int o = t * 64 + 8 * sq;
            const f32x4 a0 = *(const LAS f32x4*)(sA + o), a1 = *(const LAS f32x4*)(sA + o + 4);
            const f32x4 w0 = *(const LAS f32x4*)(sW + o), w1 = *(const LAS f32x4*)(sW + o + 4);
            const f32x4 b0 = *(const LAS f32x4*)(sB + o), b1 = *(const LAS f32x4*)(sB + o + 4);
            const f32x4 k0 = *(const LAS f32x4*)(sK + o), k1 = *(const LAS f32x4*)(sK + o + 4);
            const f32x4 r0 = *(const LAS f32x4*)(sR + o), r1 = *(const LAS f32x4*)(sR + o + 4);
            const float vi = sV[t * 64 + si];
            float sa = (st0.x * a0.x + st0.y * a0.y) + (st0.z * a0.z + st0.w * a0.w) + (st1.x * a1.x + st1.y * a1.y) + (st1.z * a1.z + st1.w * a1.w);
            sa = sum8(sa);
            st0 = st0 * w0 + sa * b0 + vi * k0; st1 = st1 * w1 + sa * b1 + vi * k1;
            float y = (st0.x * r0.x + st0.y * r0.y) + (st0.z * r0.z + st0.w * r0.w) + (st1.x * r1.x + st1.y * r1.y) + (st1.z * r1.z + st1.w * r1.w);
            y = sum8(y);
            if (sq == 0) sY[t * 64 + si] = y;
        }
        __syncthreads();
        if (tt < ntok && (ch >= 0 || b == 0)) {
            const int lo_ = tt * 64 + j0;
            const f32x4 y0 = *(const LAS f32x4*)(sY + lo_), y1 = *(const LAS f32x4*)(sY + lo_ + 4);
            float s = (y0.x + y0.y) + (y0.z + y0.w) + (y1.x + y1.y) + (y1.z + y1.w);
            const float mean = sum8(s) * (1.0f / 64.0f);
            const f32x4 c0 = y0 - mean, c1 = y1 - mean;
            float s2 = (c0.x * c0.x + c0.y * c0.y) + (c0.z * c0.z + c0.w * c0.w) + (c1.x * c1.x + c1.y * c1.y) + (c1.z * c1.z + c1.w * c1.w);
            const float rstd = 1.0f / sqrtf(sum8(s2) * (1.0f / 64.0f) + GN_EPS);
            const f32x4 r0 = *(const LAS f32x4*)(sR + lo_), r1 = *(const LAS f32x4*)(sR + lo_ + 4);
            const f32x4 k0 = *(const LAS f32x4*)(sK + lo_), k1 = *(const LAS f32x4*)(sK + lo_ + 4);
            const f32x4 v0 = *(const LAS f32x4*)(sV + lo_), v1 = *(const LAS f32x4*)(sV + lo_ + 4);
            const f32x4 g0 = *(const LAS f32x4*)(sG + lo_), g1 = *(const LAS f32x4*)(sG + lo_ + 4);
            const f32x4 p0 = r0 * k0 * rk0, p1 = r1 * k1 * rk1;
            float bs = (p0.x + p0.y) + (p0.z + p0.w) + (p1.x + p1.y) + (p1.z + p1.w);
            bs = sum8(bs);
            const f32x4 o0 = (c0 * rstd * gw0 + gb0 + bs * v0) * g0, o1 = (c1 * rstd * gw1 + gb1 + bs * v1) * g1;
            *(u32x4*)(Og + (size_t)m * D + hc) = pack8(o0, o1);
        }
        __syncthreads();
    }
}

__device__ __forceinline__ int kv_lds_off(int row, int ch) { return row * 128 + ((ch ^ (row & 7)) << 4); }
__device__ __forceinline__ int crow(int r, int hi) { return (r & 3) + 8 * (r >> 2) + 4 * hi; }
__device__ __forceinline__ void attn_phase(const Frame& F, const Args& a) {
    const int tid = F.tid, lane = F.lane, wid = F.wave, r32 = lane & 31, hi = lane >> 5;
    LAS unsigned char* sKt = F.lds; LAS unsigned char* sVt = F.lds + 24576;
    const bf16_t* Qg = (const bf16_t*)(F.ws + B_Q); const bf16_t* Kc = (const bf16_t*)(F.ws + B_KC); const bf16_t* Vc = (const bf16_t*)(F.ws + B_VC);
    bf16_t* Og = (bf16_t*)(F.ws + B_AO);
    const int g = wid >> 1, half = wid & 1;
    for (int u = F.vcu; u < NB * NKV * (SEQ / 64); u += F.G) {
        const int qt = u & 63, kvh = (u >> 6) & 3, b = u >> 8;
        const int t0 = qt * 64, p0 = t0 - 112;
        const int head = kvh * 4 + g;
#pragma unroll
        for (int i = 0; i < 3; ++i) {
            const int idx = tid + 512 * i, row = idx >> 3, ch = idx & 7, p = p0 + row;
            u32x4 kv = {0u, 0u, 0u, 0u}, vv = {0u, 0u, 0u, 0u};
            if (p >= 0) { const size_t o = (size_t)(b * LTOT + p) * 256 + kvh * 64 + ch * 8; kv = *(const u32x4*)(Kc + o); vv = *(const u32x4*)(Vc + o); }
            *(LAS u32x4*)(sKt + kv_lds_off(row, ch)) = kv; *(LAS u32x4*)(sVt + kv_lds_off(row, ch)) = vv;
        }
        const int mq = b * SEQ + t0 + half * 32 + r32;
        bf16x8 qf[4];
#pragma unroll
        for (int ds = 0; ds < 4; ++ds) qf[ds] = *(const bf16x8*)(Qg + (size_t)mq * D + head * 64 + ds * 16 + hi * 8);
        __syncthreads();
        f32x16 p[5];
#pragma unroll
        for (int i = 0; i < 5; ++i) {
            p[i] = (f32x16){0.f, 0.f, 0.f, 0.f, 0.f, 0.f, 0.f, 0.f, 0.f, 0.f, 0.f, 0.f, 0.f, 0.f, 0.f, 0.f};
            const int krow = (half + i) * 32 + r32;
#pragma unroll
            for (int ds = 0; ds < 4; ++ds) {
                const bf16x8 kf = *(const LAS bf16x8*)(sKt + kv_lds_off(krow, 2 * ds + hi));
                p[i] = __builtin_amdgcn_mfma_f32_32x32x16_bf16(kf, qf[ds], p[i], 0, 0, 0);
            }
        }
        const int pq = t0 + NMETA + half * 32 + r32;
        const float sink = a.in[I_SINK][head];
        float mx = sink;
#pragma unroll
        for (int i = 0; i < 5; ++i)
#pragma unroll
            for (int r = 0; r < 16; ++r) { const int pk = p0 + (half + i) * 32 + crow(r, hi); const bool ok = (pk >= 0) && (pk <= pq) && (pk + 127 >= pq);
                p[i][r] = ok ? p[i][r] : -INFINITY; mx = fmaxf(mx, p[i][r]); }
        mx = fmaxf(mx, __shfl_xor(mx, 32));
        float den = 0.f;
#pragma unroll
        for (int i = 0; i < 5; ++i)
#pragma unroll
            for (int r = 0; r < 16; ++r) { const float e = __expf(p[i][r] - mx); p[i][r] = e; den += e; }
        den += __shfl_xor(den, 32);
        den += __expf(sink - mx);
        const float rden = 1.0f / den;
        f32x16 o[2];
        o[0] = (f32x16){0.f, 0.f, 0.f, 0.f, 0.f, 0.f, 0.f, 0.f, 0.f, 0.f, 0.f, 0.f, 0.f, 0.f, 0.f, 0.f}; o[1] = o[0];
        const int grp = lane >> 4, li = lane & 15, tq = li >> 2, tp = li & 3;
#pragma unroll
        for (int i = 0; i < 5; ++i)
#pragma unroll
            for (int s = 0; s < 2; ++s) {
                u32x4 pw; pw.x = pk2(p[i][8 * s + 0], p[i][8 * s + 1]); pw.y = pk2(p[i][8 * s + 2], p[i][8 * s + 3]); pw.z = pk2(p[i][8 * s + 4], p[i][8 * s + 5]); pw.w = pk2(p[i][8 * s + 6], p[i][8 * s + 7]);
                const bf16x8 pb = __builtin_bit_cast(bf16x8, pw);
                const int kvb = (half + i) * 32 + 16 * s + 4 * (grp >> 1) + tq;
#pragma unroll
                for (int dt = 0; dt < 2; ++dt) {
                    const int col = dt * 32 + 16 * (grp & 1) + 4 * tp;
                    const int o1 = kv_lds_off(kvb, col >> 3) + ((col >> 2) & 1) * 8, o2 = kv_lds_off(kvb + 8, col >> 3) + ((col >> 2) & 1) * 8;
                    const s16x4 v1 = __builtin_bit_cast(s16x4, __builtin_amdgcn_ds_read_tr16_b64_v4i16((LAS s16x4*)(sVt + o1)));
                    const s16x4 v2 = __builtin_bit_cast(s16x4, __builtin_amdgcn_ds_read_tr16_b64_v4i16((LAS s16x4*)(sVt + o2)));
                    const bf16x8 va = (bf16x8){v1[0], v1[1], v1[2], v1[3], v2[0], v2[1], v2[2], v2[3]};
                    o[dt] = __builtin_amdgcn_mfma_f32_32x32x16_bf16(va, pb, o[dt], 0, 0, 0);
                }
            }
        bf16_t* orow = Og + (size_t)mq * D + head * 64;
#pragma unroll
        for (int dt = 0; dt < 2; ++dt)
#pragma unroll
            for (int r4 = 0; r4 < 4; ++r4) {
                const int d = dt * 32 + 8 * r4 + 4 * hi;
                *(u32x2*)(orow + d) = (u32x2){pk2(o[dt][4 * r4] * rden, o[dt][4 * r4 + 1] * rden), pk2(o[dt][4 * r4 + 2] * rden, o[dt][4 * r4 + 3] * rden)};
            }
        __syncthreads();
    }
}

constexpr int N_PHASES = 17;
__global__ void __launch_bounds__(NTHREADS, 2) yoco_fwd(Args args) {
    extern __shared__ __attribute__((aligned(16))) unsigned char lds[];
    Frame F;
    F.lds = (LAS unsigned char*)lds;
    F.tid = threadIdx.x; F.lane = F.tid & 63; F.wave = __builtin_amdgcn_readfirstlane(F.tid >> 6);
    F.G = gridDim.x; { const int bx = blockIdx.x; F.vcu = (F.G % 8 == 0) ? (bx % 8) * (F.G / 8) + bx / 8 : bx; }
    F.ws = args.ws; F.dout = (unsigned char*)args.out;
    volatile LAS unsigned* MISC = (volatile LAS unsigned*)(F.lds + MISC_OFF);
    for (int u = F.tid; u < (LDS_BYTES - LDSCTL_OFF) / 4; u += NTHREADS) ((LAS unsigned*)(F.lds + LDSCTL_OFF))[u] = 0u;
    __syncthreads();
    XcdBarrier bar; bar.bar = (unsigned*)(F.ws + WS_CTL) + CW_BAR; bar.x = 0; bar.st = nullptr;
    const int lo = args.ph_lo, hi = args.ph_hi;
    if (hi - lo > 1) bar = xcd_barrier_post((unsigned*)(F.ws + WS_CTL) + CW_BAR, MISC + 8);
#define IN(k) (lo <= (k) && (k) < hi)
#define SEAM(k) do { if (IN(k) && IN((k) + 1)) xcd_barrier(bar); } while (0)
    const int bx = blockIdx.x;
    unsigned char* ws = F.ws;
    const float* lng = args.in[I_LNG]; const float* lnb = args.in[I_LNB];

    if (IN(0)) { p0_prologue(F, args); } SEAM(0);
    if (IN(1)) {
        pg8::StaticOrder S; S.init(M, N_G1, F.G, bx);
        const AMapG1 AM{(const char*)ws}; const pg8::Epi8<EpiG1> E{{ws, F.dout}};
        pg8::gemm_phase(F.lds, AM, (const bf16_t*)(ws + WT_G1), D, S, E);
        meta_gemm(F.lds, AM, (const bf16_t*)(ws + WT_G1), N_G1, D, F.vcu, F.G, E.f);
    } SEAM(1);
    if (IN(2)) { lora_combine(F); } SEAM(2);
    if (IN(3)) {
        pg8::StaticOrder S; S.init(M, N_L2, F.G, bx);
        const AMapPlain AM{(const char*)(F.dout + DO_LA), (size_t)256 * 256 * 2}; const pg8::Epi8<EpiL2> E{{ws, args.in[I_W0], args.in[I_A0]}};
        pg8::gemm_phase(F.lds, AM, (const bf16_t*)(ws + WT_L2), 256, S, E);
        meta_gemm(F.lds, AM, (const bf16_t*)(ws + WT_L2), N_L2, 256, F.vcu, F.G, E.f);
    } SEAM(3);
    if (IN(4)) { scan_phase(F, args); } SEAM(4);
    if (IN(5)) {
        pg8::StaticOrder S; S.init(M, D, F.G, bx);
        const AMapPlain AM{(const char*)(F.dout + DO_O), (size_t)256 * D * 2}; const pg8::Epi8<EpiRes> E{{ws, args.in[I_X], args.in[I_META]}};
        pg8::gemm_phase(F.lds, AM, (const bf16_t*)(ws + WT_O0), D, S, E);
        meta_gemm(F.lds, AM, (const bf16_t*)(ws + WT_O0), D, D, F.vcu, F.G, E.f);
    } SEAM(5);
    if (IN(6)) { ln_phase(F, lng + 0 * D, lnb + 0 * D, nullptr); } SEAM(6);
    if (IN(7)) {
        pg8::StaticOrder S; S.init(M, FF, F.G, bx);
        const AMapPlain AM{(const char*)(ws + B_HB), (size_t)256 * D * 2}; const pg8::Epi8<EpiUp> E{{ws}};
        pg8::gemm_phase(F.lds, AM, (const bf16_t*)(ws + WT_UP0), D, S, E);
        meta_gemm(F.lds, AM, (const bf16_t*)(ws + WT_UP0), FF, D, F.vcu, F.G, E.f);
    } SEAM(7);
    if (IN(8)) {
        pg8::StaticOrder S; S.init(M, D, F.G, bx);
        const AMapPlain AM{(const char*)(ws + B_U), (size_t)256 * FF * 2}; const pg8::Epi8<EpiRes> E{{ws, nullptr, nullptr}};
        pg8::gemm_phase(F.lds, AM, (const bf16_t*)(ws + WT_DN0), FF, S, E);
        meta_gemm(F.lds, AM, (const bf16_t*)(ws + WT_DN0), D, FF, F.vcu, F.G, E.f);
    } SEAM(8);
    if (IN(9)) { ln_phase(F, lng + 1 * D, lnb + 1 * D, nullptr); } SEAM(9);
    if (IN(10)) {
        pg8::StaticOrder S; S.init(M, N_QKV, F.G, bx);
        const AMapPlain AM{(const char*)(ws + B_HB), (size_t)256 * D * 2}; const pg8::Epi8<EpiQKV> E{{ws}};
        pg8::gemm_phase(F.lds, AM, (const bf16_t*)(ws + WT_QKV), D, S, E);
        meta_gemm(F.lds, AM, (const bf16_t*)(ws + WT_QKV), N_QKV, D, F.vcu, F.G, E.f, 1024 / 32);
    } SEAM(10);
    if (IN(11)) { attn_phase(F, args); } SEAM(11);
    if (IN(12)) {
        pg8::StaticOrder S; S.init(M, D, F.G, bx);
        const AMapPlain AM{(const char*)(ws + B_AO), (size_t)256 * D * 2}; const pg8::Epi8<EpiRes> E{{ws, nullptr, nullptr}};
        pg8::gemm_phase(F.lds, AM, (const bf16_t*)(ws + WT_O1), D, S, E);
    } SEAM(12);
    if (IN(13)) { ln_phase(F, lng + 2 * D, lnb + 2 * D, nullptr); } SEAM(13);
    if (IN(14)) {
        pg8::StaticOrder S; S.init(M, FF, F.G, bx);
        const AMapPlain AM{(const char*)(ws + B_HB), (size_t)256 * D * 2}; const pg8::Epi8<EpiUp> E{{ws}};
        pg8::gemm_phase(F.lds, AM, (const bf16_t*)(ws + WT_UP1), D, S, E);
    } SEAM(14);
    if (IN(15)) {
        pg8::StaticOrder S; S.init(M, D, F.G, bx);
        const AMapPlain AM{(const char*)(ws + B_U), (size_t)256 * FF * 2}; const pg8::Epi8<EpiRes> E{{ws, nullptr, nullptr}};
        pg8::gemm_phase(F.lds, AM, (const bf16_t*)(ws + WT_DN1), FF, S, E);
    } SEAM(15);
    if (IN(16)) { ln_phase(F, lng + 3 * D, lnb + 3 * D, args.out); }
#undef IN
#undef SEAM
}

extern "C" void kernel_launch(void* const* d_in, const int* in_sizes, int n_in, void* d_out, int out_size, void* d_ws, size_t ws_size, hipStream_t stream) {
    static int grid = 0;
    if (grid == 0) {
        if (n_in != 29 || in_sizes[0] != M * D || out_size != M * D || ws_size < WS_END) { fprintf(stderr, "kernel_launch: unexpected shapes (n_in %d, in0 %d, out %d, ws %zu)\n", n_in, n_in > 0 ? in_sizes[0] : -1, out_size, ws_size); grid = -1; return; }
        int dev = 0, cus = 0;
        if (hipGetDevice(&dev) != hipSuccess || hipDeviceGetAttribute(&cus, hipDeviceAttributeMultiprocessorCount, dev) != hipSuccess) { grid = -1; return; }
        if (hipFuncSetAttribute((const void*)yoco_fwd, hipFuncAttributeMaxDynamicSharedMemorySize, LDS_BYTES) != hipSuccess) { fprintf(stderr, "kernel_launch: hipFuncSetAttribute failed\n"); grid = -1; return; }
        (void)hipGetLastError();
        grid = cus;
    }
    if (grid < 0) return;
    if (hipMemsetAsync((char*)d_ws + WS_CTL, 0, CTL_ZERO_BYTES, stream) != hipSuccess) return;
    Args a{};
    for (int i = 0; i < 29; ++i) a.in[i] = (const float*)d_in[i];
    a.out = (float*)d_out; a.ws = (unsigned char*)d_ws;
#if MK_N_LAUNCHES == 1
    a.ph_lo = 0; a.ph_hi = N_PHASES;
    hipLaunchKernelGGL(yoco_fwd, dim3(grid), dim3(NTHREADS), LDS_BYTES, stream, a);
#else
    for (int p = 0; p < N_PHASES; ++p) { a.ph_lo = p; a.ph_hi = p + 1; hipLaunchKernelGGL(yoco_fwd, dim3(grid), dim3(NTHREADS), LDS_BYTES, stream, a); }
#endif
}
```

```cpp
#include <hip/hip_runtime.h>
#include <cstdio>
#include <cstdint>

#ifndef MK_N_LAUNCHES
#define MK_N_LAUNCHES 1
#endif

#define LAS __attribute__((address_space(3)))
#define GAS __attribute__((address_space(1)))
typedef unsigned short bf16_t;
typedef short bf16x8 __attribute__((ext_vector_type(8)));
typedef short s16x4 __attribute__((ext_vector_type(4)));
typedef float f32x2 __attribute__((ext_vector_type(2)));
typedef float f32x4 __attribute__((ext_vector_type(4)));
typedef float f32x16 __attribute__((ext_vector_type(16)));
typedef unsigned u32x2 __attribute__((ext_vector_type(2)));
typedef unsigned u32x4 __attribute__((ext_vector_type(4)));

constexpr int D = 1024, NB = 8, SEQ = 4096, NMETA = 16, LTOT = SEQ + NMETA;
constexpr int M = NB * SEQ;
constexpr int MR = M + NMETA;
constexpr int FF = 4096, HD = 64, NH = 16, NKV = 4;
constexpr float LN_EPS = 1e-5f, GN_EPS = 64e-5f;
constexpr float ALPHA = 1.41421356237309515f;
constexpr int N_G1 = 3584;
constexpr int N_L2 = 3072;
constexpr int N_QKV = 1536;

constexpr size_t MiB = 1u << 20;
constexpr size_t WS_CTL = 0, CTL_ZERO_BYTES = 1 * MiB;
constexpr size_t WS_ROPE = 1 * MiB;
constexpr size_t WS_W = 4 * MiB;
constexpr size_t WT_G1 = WS_W;
constexpr size_t WT_L2 = WT_G1 + 7 * MiB;
constexpr size_t WT_O0 = WT_L2 + 3 * MiB / 2;
constexpr size_t WT_UP0 = WT_O0 + 2 * MiB;
constexpr size_t WT_DN0 = WT_UP0 + 8 * MiB;
constexpr size_t WT_QKV = WT_DN0 + 8 * MiB;
constexpr size_t WT_O1 = WT_QKV + 3 * MiB;
constexpr size_t WT_UP1 = WT_O1 + 2 * MiB;
constexpr size_t WT_DN1 = WT_UP1 + 8 * MiB;
constexpr size_t WS_SLOT0 = 52 * MiB, SLOT = 65 * MiB;
constexpr size_t S0 = WS_SLOT0, S1 = S0 + SLOT, S2 = S1 + SLOT, S3 = S2 + SLOT, S4 = S3 + SLOT, S5 = S4 + SLOT, S6 = S5 + SLOT;
constexpr size_t WS_END = S6 + SLOT;
static_assert(WT_DN1 + 8 * MiB <= WS_SLOT0, "weights fit");
static_assert(WS_END <= 512 * MiB, "workspace");
constexpr size_t B_XR = S0, B_XK = S1, B_XV = S2, B_XB = S3;
constexpr size_t B_R = S4, B_K = S5, B_V = S6;
constexpr size_t B_LD = S0;
constexpr size_t B_A = S2, B_G = S3;
constexpr size_t B_RS = S0;
constexpr size_t B_HB = S2;
constexpr size_t B_U = S3;
constexpr size_t B_Q = S3;
constexpr size_t B_KC = S4, B_VC = S4 + 32 * MiB;
constexpr size_t B_AO = S5;
constexpr size_t DO_LP = 0, DO_LA = 40 * MiB, DO_O = 0;

constexpr int CW_BAR = 4096;

__device__ __forceinline__ unsigned f2bf(float f) { unsigned u = __builtin_bit_cast(unsigned, f); return (u + 0x7fffu + ((u >> 16) & 1u)) >> 16; }
typedef __bf16 bf16x2_t __attribute__((ext_vector_type(2)));
__device__ __forceinline__ unsigned pk2(float lo, float hi) { const f32x2 v = {lo, hi}; return __builtin_bit_cast(unsigned, __builtin_convertvector(v, bf16x2_t)); }
__device__ __forceinline__ float bf_lo(unsigned w) { return __builtin_bit_cast(float, w << 16); }
__device__ __forceinline__ float bf_hi(unsigned w) { return __builtin_bit_cast(float, w & 0xffff0000u); }
__device__ __forceinline__ u32x4 pack8(f32x4 a, f32x4 b) { u32x4 w; w.x = pk2(a.x, a.y); w.y = pk2(a.z, a.w); w.z = pk2(b.x, b.y); w.w = pk2(b.z, b.w); return w; }
__device__ __forceinline__ void unpack8(u32x4 w, f32x4& a, f32x4& b) { a.x = bf_lo(w.x); a.y = bf_hi(w.x); a.z = bf_lo(w.y); a.w = bf_hi(w.y); b.x = bf_lo(w.z); b.y = bf_hi(w.z); b.z = bf_lo(w.w); b.w = bf_hi(w.w); }
template <int CTRL> __device__ __forceinline__ float dppf(float x) { return __builtin_bit_cast(float, __builtin_amdgcn_update_dpp(0, __builtin_bit_cast(int, x), CTRL, 0xF, 0xF, true)); }
__device__ __forceinline__ float sum8(float x) { x += dppf<0xB1>(x); x += dppf<0x4E>(x); x += dppf<0x141>(x); return x; }
__device__ __forceinline__ float wave_sum(float v) {
#pragma unroll
    for (int o = 1; o < 64; o <<= 1) v += __shfl_xor(v, o);
    return v;
}
__device__ __forceinline__ float sigmoidf_(float z) { return 1.0f / (1.0f + __expf(-z)); }
__device__ __forceinline__ int xb_row(int m) { return (m >> 12) * (SEQ + 1) + (m & (SEQ - 1)) + 1; }

namespace pg8 {
constexpr int BM = 256, BK = 64, HALF = 128, HTB = HALF * BK * 2, STAGE_BYTES = 8 * HTB, NXCD = 8, WGM = 8;
__host__ __device__ __forceinline__ int lds_byte(int r, int c) { const int st = (r >> 4) * 2 + (c >> 5), rr = r & 15, cc = c & 31, ob = rr * 64 + cc * 2; return st * 1024 + (ob ^ (((ob >> 9) & 1) << 5)); }
__host__ __device__ __forceinline__ void stage_rc(int b, int& R, int& C) { const int st = b / 1024, sb = b % 1024, swz = sb ^ (((sb >> 9) & 1) << 5); R = (st >> 1) * 16 + swz / 64; C = (st & 1) * 32 + (swz % 64) / 2; }
__host__ __device__ __forceinline__ int perm32(int rho) { const int n = rho >> 4, i = rho & 15; return 8 * (i >> 2) + 4 * n + (i & 3); }
struct Unit { int pm, pn; };
struct StaticOrder {
    int nM, nN, nwg, G, c;
    __host__ __device__ void init(int M_, int N_, int G_, int c_) { nM = M_ / BM; nN = N_ / BM; nwg = nM * nN; G = G_; c = c_; }
    __host__ __device__ bool next(int i, Unit& u) const {
        const long L = (long)i * G + c; if (L >= nwg) return false;
        int wgid = (int)L; { const int q = nwg / NXCD, r = nwg % NXCD, xcd = wgid % NXCD, off = wgid / NXCD; wgid = (xcd < r ? xcd * (q + 1) : r * (q + 1) + (xcd - r) * q) + off; }
        const int nig = WGM * nN, gid = wgid / nig, fm = gid * WGM, gsz = (nM - fm) < WGM ? (nM - fm) : WGM;
        u.pm = fm + ((wgid % nig) % gsz); u.pn = (wgid % nig) / gsz; return true;
    }
};
template <class F> struct Epi8 {
    F f;
    __device__ __forceinline__ void operator()(const f32x4 (&acc)[2][2][4][2], const Unit& u, int wr, int wc, int fr, int fq) const {
        const int row0 = u.pm * BM + wr * 64 + fr, col0 = u.pn * BM + wc * 32 + 8 * fq;
#pragma unroll
        for (int ai = 0; ai < 2; ++ai)
#pragma unroll
            for (int m = 0; m < 4; ++m)
#pragma unroll
                for (int bj = 0; bj < 2; ++bj) f(row0 + ai * HALF + m * 16, col0 + bj * HALF, acc[ai][bj][m][0], acc[ai][bj][m][1]);
    }
};

template <class Epi, class AMap>
__device__ __forceinline__ void gemm_phase(LAS unsigned char* lds, const AMap AM, const bf16_t* Bt, int K, const StaticOrder& S, const Epi& E) {
    const int tid = threadIdx.x, wid = __builtin_amdgcn_readfirstlane(tid >> 6), lane = tid & 63, wr = wid >> 2, wc = wid & 3, fr = lane & 15, fq = lane >> 4;
    const int nt = K / BK;
    unsigned voffA[2], voffB[2];
#pragma unroll
    for (int i = 0; i < 2; ++i) { int R, C; stage_rc(tid * 16 + i * 8192, R, C); const int Rb = (R & ~31) + perm32(R & 31);
        voffA[i] = (unsigned)(R * K + C) * 2u; voffB[i] = (unsigned)(Rb * K + C) * 2u; }
    const size_t kstep = (size_t)(BK * 2);
    const size_t hstep = (size_t)HALF * K * 2;
    const size_t tstep = 2 * hstep;
    const unsigned ldsw = (unsigned)wid * 1024u;
    const int aoff = lds_byte(wr * 64 + fr, fq * 8), boff = lds_byte(wc * 32 + fr, fq * 8);
#define PG8_SA(b, h) (((b) * 2 + (h)) * HTB)
#define PG8_SB(b, h) ((4 + (b) * 2 + (h)) * HTB)
#define PG8_STAGE(bufoff, gbase, voff) do { _Pragma("unroll") for (int _i = 0; _i < 2; ++_i) \
        __builtin_amdgcn_global_load_lds((const unsigned*)((const char*)(gbase) + (voff)[_i]), (LAS unsigned*)(lds + (bufoff) + ldsw + _i * 8192), 16, 0, 0); } while (0)
#define PG8_LDA(dst, b, h) do { _Pragma("unroll") for (int m = 0; m < 4; ++m) _Pragma("unroll") for (int k = 0; k < 2; ++k) dst[m][k] = *(const LAS bf16x8*)(lds + PG8_SA(b, h) + aoff + m * 2048 + k * 1024); } while (0)
#define PG8_LDB(dst, b, h) do { _Pragma("unroll") for (int n = 0; n < 2; ++n) _Pragma("unroll") for (int k = 0; k < 2; ++k) dst[n][k] = *(const LAS bf16x8*)(lds + PG8_SB(b, h) + boff + n * 2048 + k * 1024); } while (0)
#define PG8_MMA(ai, bj, At, Bt_) do { __builtin_amdgcn_s_setprio(1); _Pragma("unroll") for (int m = 0; m < 4; ++m) _Pragma("unroll") for (int n = 0; n < 2; ++n) _Pragma("unroll") for (int k = 0; k < 2; ++k) \
        acc[ai][bj][m][n] = __builtin_amdgcn_mfma_f32_16x16x32_bf16(Bt_[n][k], At[m][k], acc[ai][bj][m][n], 0, 0, 0); __builtin_amdgcn_s_setprio(0); } while (0)
#define PG8_WAIT_V(n) asm volatile("s_waitcnt vmcnt(" #n ")" ::: "memory")
#define PG8_WAIT_L(n) asm volatile("s_waitcnt lgkmcnt(" #n ")" ::: "memory")
#define PG8_BAR __builtin_amdgcn_s_barrier()
#define PG8_SCHED __builtin_amdgcn_sched_barrier(0)
    Unit cur, nxt; int ui = 0;
    if (!S.next(0, cur)) return;
    f32x4 acc[2][2][4][2];
#pragma unroll
    for (int a = 0; a < 2; ++a)
#pragma unroll
        for (int b = 0; b < 2; ++b)
#pragma unroll
            for (int m = 0; m < 4; ++m)
#pragma unroll
                for (int n = 0; n < 2; ++n) acc[a][b][m][n] = (f32x4){0.f, 0.f, 0.f, 0.f};
    bf16x8 At[4][2], B0[2][2], B1[2][2];
    const char* cA = AM.tile(cur.pm, cur.pn); const char* cB = (const char*)Bt + (size_t)cur.pn * tstep;
    PG8_STAGE(PG8_SB(0, 0), cB, voffB); PG8_STAGE(PG8_SB(0, 1), cB + hstep, voffB); PG8_STAGE(PG8_SA(0, 0), cA, voffA); PG8_STAGE(PG8_SA(0, 1), cA + hstep, voffA);
    if (wr == 1) PG8_BAR;
    PG8_WAIT_V(2); PG8_BAR;
    PG8_STAGE(PG8_SB(1, 0), cB + kstep, voffB); PG8_STAGE(PG8_SA(1, 0), cA + kstep, voffA); PG8_STAGE(PG8_SB(1, 1), cB + hstep + kstep, voffB);
    PG8_WAIT_V(6); PG8_BAR;
    for (;;) {
        const bool has_next = S.next(ui + 1, nxt);
        const char* nA = has_next ? AM.tile(nxt.pm, nxt.pn) : cA; const char* nB = has_next ? (const char*)Bt + (size_t)nxt.pn * tstep : cB;
        for (int t = 0; t < nt; t += 2) {
            const bool last = (t == nt - 2);
            const char* a1 = cA + (size_t)(t + 1) * kstep;
            const char* a2 = last ? nA : cA + (size_t)(t + 2) * kstep; const char* b2 = last ? nB : cB + (size_t)(t + 2) * kstep;
            const char* a3 = a2 + kstep; const char* b3 = b2 + kstep;
            PG8_LDB(B0, 0, 0); PG8_LDB(B1, 0, 1); PG8_SCHED; PG8_LDA(At, 0, 0); PG8_STAGE(PG8_SA(1, 1), a1 + hstep, voffA);
            PG8_WAIT_V(8); PG8_WAIT_L(0); PG8_BAR; PG8_MMA(0, 0, At, B0); PG8_MMA(0, 1, At, B1); PG8_BAR; PG8_SCHED;
            PG8_LDA(At, 0, 1); PG8_STAGE(PG8_SB(0, 0), b2, voffB); PG8_STAGE(PG8_SB(0, 1), b2 + hstep, voffB); PG8_STAGE(PG8_SA(0, 0), a2, voffA);
            PG8_WAIT_V(8); PG8_WAIT_L(0); PG8_BAR; PG8_MMA(1, 0, At, B0); PG8_MMA(1, 1, At, B1); PG8_BAR; PG8_SCHED;
            PG8_LDB(B0, 1, 0); PG8_LDB(B1, 1, 1); PG8_SCHED; PG8_LDA(At, 1, 0); PG8_STAGE(PG8_SA(0, 1), a2 + hstep, voffA);
            PG8_WAIT_V(8); PG8_WAIT_L(0); PG8_BAR; PG8_MMA(0, 0, At, B0); PG8_MMA(0, 1, At, B1); PG8_BAR; PG8_SCHED;
            PG8_LDA(At, 1, 1); PG8_STAGE(PG8_SB(1, 0), b3, voffB); PG8_STAGE(PG8_SB(1, 1), b3 + hstep, voffB); PG8_STAGE(PG8_SA(1, 0), a3, voffA);
            PG8_WAIT_V(8); PG8_WAIT_L(0); PG8_BAR; PG8_MMA(1, 0, At, B0); PG8_MMA(1, 1, At, B1); PG8_BAR; PG8_SCHED;
        }
        if (wr == 0) PG8_BAR;
        E(acc, cur, wr, wc, fr, fq);
        if (!has_next) break;
#pragma unroll
        for (int a = 0; a < 2; ++a)
#pragma unroll
            for (int b = 0; b < 2; ++b)
#pragma unroll
                for (int m = 0; m < 4; ++m)
#pragma unroll
                    for (int n = 0; n < 2; ++n) acc[a][b][m][n] = (f32x4){0.f, 0.f, 0.f, 0.f};
        cur = nxt; cA = nA; cB = nB; ++ui;
        if (wr == 1) PG8_BAR;
    }
    PG8_WAIT_V(0);
    PG8_BAR;
#undef PG8_SA
#undef PG8_SB
#undef PG8_STAGE
#undef PG8_LDA
#undef PG8_LDB
#undef PG8_MMA
#undef PG8_WAIT_V
#undef PG8_WAIT_L
#undef PG8_BAR
#undef PG8_SCHED
}
}

#define XB_TMO      128
#define XB_XCNT(j)  (256  + 64 * (j))
#define XB_XSUB(j)  (1280 + 64 * (j))
#define XB_XGEN(j)  (2304 + 64 * (j))
#define XB_TOP      3328
#define XB_TOPGEN   3392
#define XCD_BAR_WORDS 3456
#define XB_SPIN_CAP (1u << 18)
__device__ __forceinline__ unsigned xb_ld(unsigned* p)              { return __hip_atomic_load(p, __ATOMIC_RELAXED, __HIP_MEMORY_SCOPE_AGENT); }
__device__ __forceinline__ unsigned xb_add(unsigned* p, unsigned v) { return __hip_atomic_fetch_add(p, v, __ATOMIC_RELAXED, __HIP_MEMORY_SCOPE_AGENT); }
__device__ __forceinline__ unsigned xb_xcc_id() { return (unsigned)__builtin_amdgcn_s_getreg((3 << 11) | 20) & 0xFu; }
#define XB_SPIN(cond, bar) do { unsigned _sp = 0; while (cond) { __builtin_amdgcn_s_sleep(1); \
    if ((++_sp & 255u) == 0u) { if (xb_ld(&(bar)[XB_TMO])) break; if (_sp > XB_SPIN_CAP) { atomicAdd(&(bar)[XB_TMO], 1u); break; } } } } while (0)
struct XcdBarrier { unsigned* bar; unsigned x; volatile LAS unsigned* st; };
__device__ __forceinline__ XcdBarrier xcd_barrier_post(unsigned* bar, volatile LAS unsigned* st) {
    XcdBarrier b; b.bar = bar; b.x = xb_xcc_id(); b.st = st;
    if (threadIdx.x == 0) (void)xb_add(&bar[XB_XCNT(b.x)], 1u);
    return b;
}
__device__ __forceinline__ void xcd_barrier_complete(unsigned* bar, unsigned x, unsigned& nloc, unsigned& nx) {
    const unsigned G = gridDim.x * gridDim.y * gridDim.z;
    unsigned sum, cnt, mine, sp = 0u;
    for (;;) {
        sum = 0u; cnt = 0u; mine = 0u;
#pragma unroll
        for (unsigned j = 0; j < 16; ++j) { const unsigned c = xb_ld(&bar[XB_XCNT(j)]); sum += c; cnt += (c > 0u) ? 1u : 0u; mine = (j == x) ? c : mine; }
        if (sum == G) break;
        __builtin_amdgcn_s_sleep(1);
        if ((++sp & 255u) == 0u) { if (xb_ld(&bar[XB_TMO])) break; if (sp > XB_SPIN_CAP) { atomicAdd(&bar[XB_TMO], 1u); break; } }
    }
    nloc = mine > 0u ? mine : 1u; nx = cnt > 0u ? cnt : 1u;
}
__device__ __forceinline__ void xcd_barrier(const XcdBarrier& b) {
    asm volatile("s_waitcnt vmcnt(0)" ::: "memory");
    __syncthreads();
    if (threadIdx.x == 0) {
        unsigned* bar = b.bar;
        __builtin_amdgcn_s_waitcnt(0);
        unsigned nloc = b.st[0], nx = b.st[1];
        if (nloc == 0u) { xcd_barrier_complete(bar, b.x, nloc, nx); b.st[0] = nloc; b.st[1] = nx; }
        const unsigned old = xb_add(&bar[XB_XSUB(b.x)], 1u);
        const unsigned gen = old / nloc;
        if (old + 1u == (gen + 1u) * nloc) {
            __builtin_amdgcn_fence(__ATOMIC_RELEASE, "agent");
            asm volatile("s_waitcnt vmcnt(0)" ::: "memory");
            const unsigned og = xb_add(&bar[XB_TOP], 1u);
            const unsigned tg = og / nx;
            if (og + 1u == (tg + 1u) * nx) xb_add(&bar[XB_TOPGEN], 1u);
            else XB_SPIN(xb_ld(&bar[XB_TOPGEN]) == tg, bar);
            __builtin_amdgcn_fence(__ATOMIC_ACQUIRE, "agent");
            xb_add(&bar[XB_XGEN(b.x)], 1u);
            asm volatile("s_waitcnt vmcnt(0)" ::: "memory");
        } else {
            XB_SPIN(xb_ld(&bar[XB_XGEN(b.x)]) == gen, bar);
            __builtin_amdgcn_fence(__ATOMIC_ACQUIRE, "agent");
            asm volatile("s_waitcnt vmcnt(0)" ::: "memory");
        }
    }
    __syncthreads();
}

constexpr int RING_BYTES = 131072;
constexpr int LDS_BYTES = 159744;
constexpr int LDSCTL_OFF = LDS_BYTES - 512, MISC_OFF = LDSCTL_OFF + 320;
constexpr int NWAVES = 8, NTHREADS = 512;

struct Args { const float* in[29]; float* out; unsigned char* ws; int ph_lo, ph_hi; };
enum { I_X = 0, I_META, I_MU, I_WR, I_WK, I_WV, I_WO, I_W0, I_W1, I_W2, I_A0, I_A1, I_A2, I_G1, I_G2, I_KK, I_KA, I_RK, I_GNW, I_GNB,
       I_KVK, I_KVV, I_WQ, I_SINK, I_BWO, I_UP, I_DN, I_LNG, I_LNB };

struct AMapPlain {
    const char* A; size_t tile_bytes;
    __device__ __forceinline__ const char* tile(int pm, int) const { return A + (size_t)pm * tile_bytes; }
    __device__ __forceinline__ const char* row(int m, int, int K) const { return A + (size_t)m * K * 2; }
};
struct AMapG1 {
    const char* ws;
    __device__ __forceinline__ const char* row(int m, int pn, int) const {
        if (pn < 12) return ws + (pn < 4 ? B_XR : (pn < 8 ? B_XK : B_XV)) + (size_t)m * (D * 2);
        return ws + B_XB + (size_t)(xb_row(m) - (pn == 13 ? 1 : 0)) * (D * 2);
    }
    __device__ __forceinline__ const char* tile(int pm, int pn) const { return row(pm * 256, pn, D); }
};

template <class AMap, class F>
__device__ __forceinline__ void meta_gemm(LAS unsigned char* lds, const AMap AM, const bf16_t* Bt, int N, int K, int vcu, int G, const F& f, int cg_lo = 0, int cg_hi = -1) {
    const int tid = threadIdx.x, wid = __builtin_amdgcn_readfirstlane(tid >> 6), lane = tid & 63, tok = lane & 15, fq = lane >> 4;
    if (cg_hi < 0) cg_hi = N / 32;
    const int kw = K / 8;
    LAS f32x4* red = (LAS f32x4*)lds;
    for (int cg = cg_lo + vcu; cg < cg_hi; cg += G) {
        const int n0 = cg * 32, pn = n0 >> 8;
        const bf16_t* xrow = (const bf16_t*)AM.row(M + tok, pn, K) + wid * kw + 8 * fq;
        const bf16_t* w0 = Bt + (size_t)(n0 + 8 * (tok >> 2) + (tok & 3)) * K + wid * kw + 8 * fq;
        const bf16_t* w1 = w0 + (size_t)4 * K;
        f32x4 c0 = {0.f, 0.f, 0.f, 0.f}, c1 = {0.f, 0.f, 0.f, 0.f};
#pragma unroll 4
        for (int k = 0; k < kw; k += 32) {
            const bf16x8 xa = *(const bf16x8*)(xrow + k), wa = *(const bf16x8*)(w0 + k), wb = *(const bf16x8*)(w1 + k);
            c0 = __builtin_amdgcn_mfma_f32_16x16x32_bf16(wa, xa, c0, 0, 0, 0);
            c1 = __builtin_amdgcn_mfma_f32_16x16x32_bf16(wb, xa, c1, 0, 0, 0);
        }
        red[(wid * 64 + lane) * 2] = c0; red[(wid * 64 + lane) * 2 + 1] = c1;
        __syncthreads();
        if (wid == 0) {
            f32x4 s0 = red[lane * 2], s1 = red[lane * 2 + 1];
#pragma unroll
            for (int w = 1; w < 8; ++w) { s0 += red[(w * 64 + lane) * 2]; s1 += red[(w * 64 + lane) * 2 + 1]; }
            f(M + tok, n0 + 8 * fq, s0, s1);
        }
        __syncthreads();
    }
}

struct EpiG1 {
    unsigned char* ws; unsigned char* dout;
    __device__ __forceinline__ void operator()(int m, int c, f32x4 lo, f32x4 hi) const {
        bf16_t* p;
        if (c < 3072) p = (bf16_t*)(ws + (c < 1024 ? B_R : (c < 2048 ? B_K : B_V))) + (size_t)m * D + (c & 1023);
        else p = (bf16_t*)(dout + DO_LP) + (size_t)m * 512 + (c - 3072);
        *(u32x4*)p = pack8(lo, hi);
    }
};
struct EpiL2 {
    unsigned char* ws; const float* w0; const float* a0;
    __device__ __forceinline__ void operator()(int m, int c, f32x4 lo, f32x4 hi) const {
        if (c < 1024) {
            const f32x4 b0 = *(const f32x4*)(w0 + c), b1 = *(const f32x4*)(w0 + c + 4);
            f32x4 o0, o1;
#pragma unroll
            for (int i = 0; i < 4; ++i) { o0[i] = -0.60653065971263342f * sigmoidf_(b0[i] + lo[i]); o1[i] = -0.60653065971263342f * sigmoidf_(b1[i] + hi[i]); }
            float* p = (float*)(ws + B_LD) + (size_t)m * D + c; *(f32x4*)p = o0; *(f32x4*)(p + 4) = o1;
        } else if (c < 2048) {
            const int cc = c - 1024; const f32x4 b0 = *(const f32x4*)(a0 + cc), b1 = *(const f32x4*)(a0 + cc + 4);
            f32x4 o0, o1;
#pragma unroll
            for (int i = 0; i < 4; ++i) { o0[i] = sigmoidf_(b0[i] + lo[i]); o1[i] = sigmoidf_(b1[i] + hi[i]); }
            *(u32x4*)((bf16_t*)(ws + B_A) + (size_t)m * D + cc) = pack8(o0, o1);
        } else {
            *(u32x4*)((bf16_t*)(ws + B_G) + (size_t)m * D + (c - 2048)) = pack8(lo, hi);
        }
    }
};
struct EpiRes {
    unsigned char* ws; const float* x; const float* meta;
    __device__ __forceinline__ void operator()(int m, int c, f32x4 lo, f32x4 hi) const {
        float* p = (float*)(ws + B_RS) + (size_t)m * D + c;
        const float* b = x ? (m < M ? x + (size_t)m * D + c : meta + (size_t)(m - M) * D + c) : p;
        const f32x4 b0 = *(const f32x4*)b, b1 = *(const f32x4*)(b + 4);
        *(f32x4*)p = b0 * ALPHA + lo; *(f32x4*)(p + 4) = b1 * ALPHA + hi;
    }
};
struct EpiUp {
    unsigned char* ws;
    __device__ __forceinline__ void operator()(int m, int c, f32x4 lo, f32x4 hi) const {
#pragma unroll
        for (int i = 0; i < 4; ++i) { const float a = fmaxf(lo[i], 0.f), b = fmaxf(hi[i], 0.f); lo[i] = a * a; hi[i] = b * b; }
        *(u32x4*)((bf16_t*)(ws + B_U) + (size_t)m * FF + c) = pack8(lo, hi);
    }
};
struct EpiQKV {
    unsigned char* ws;
    __device__ __forceinline__ void operator()(int m, int c, f32x4 lo, f32x4 hi) const {
        const int pos = m < M ? (m & (SEQ - 1)) + NMETA : m - M;
        if (c < 1280) {
            const int d0 = 4 * ((c & 63) >> 3);
            const float* ct = (const float*)(ws + WS_ROPE) + (size_t)pos * 32 + d0;
            const f32x4 cs = *(const f32x4*)ct, sn = *(const f32x4*)(ct + LTOT * 32);
            f32x4 o1 = lo * cs - hi * sn, o2 = hi * cs + lo * sn;
            if (c < 1024) { if (m >= M) return; o1 *= 0.125f; o2 *= 0.125f; *(u32x4*)((bf16_t*)(ws + B_Q) + (size_t)m * D + c) = pack8(o1, o2); return; }
            lo = o1; hi = o2;
        }
        bf16_t* base = (bf16_t*)(ws + (c < 1280 ? B_KC : B_VC)); const int cc = c < 1280 ? c - 1024 : c - 1280;
        const u32x4 w = pack8(lo, hi);
        if (m < M) { *(u32x4*)(base + (size_t)((m >> 12) * LTOT + pos) * 256 + cc) = w; }
        else {
#pragma unroll
            for (int b = 0; b < NB; ++b) *(u32x4*)(base + (size_t)(b * LTOT + pos) * 256 + cc) = w;
        }
    }
};

struct Frame {
    LAS unsigned char* lds;
    int tid, lane, wave, vcu, G;
    unsigned char* ws; unsigned char* dout;
};

struct WDesc { const float* W; int ldw; int Ksrc; int Nsrc; bf16_t* dst; int ldd; int row_off; int k_off; const float* mu; int mode; int perm; };
__device__ __forceinline__ int rope_src_col(int n) { const int j = n & 63; return (n & ~63) + ((j & 4) ? 32 : 0) + 4 * (j >> 3) + (j & 3); }
__device__ __forceinline__ void p0_transpose_item(const WDesc& d, LAS float* scr, int item, int lane) {
    const int nblk = d.Nsrc / 32, kb = item / nblk, nb = item % nblk, k0 = 64 * kb, n0 = 32 * nb;
    const int nn = n0 + (lane & 31), sc = d.perm ? rope_src_col(nn) : nn;
#pragma unroll 8
    for (int i = 0; i < 32; ++i) { const int kk = 2 * i + (lane >> 5); float v = d.W[(size_t)(k0 + kk) * d.ldw + sc];
        if (d.mode) { const float mu = d.mu[k0 + kk]; v *= (d.mode == 1 ? 1.0f - mu : mu); }
        scr[kk * 33 + (lane & 31)] = v; }
    asm volatile("s_waitcnt lgkmcnt(0)" ::: "memory");
    const int c = lane & 7;
#pragma unroll
    for (int j = 0; j < 4; ++j) { const int n = (lane >> 3) + 8 * j; const LAS float* s = scr + (8 * c) * 33 + n;
        u32x4 o; o.x = pk2(s[0 * 33], s[1 * 33]); o.y = pk2(s[2 * 33], s[3 * 33]); o.z = pk2(s[4 * 33], s[5 * 33]); o.w = pk2(s[6 * 33], s[7 * 33]);
        *(u32x4*)(d.dst + (size_t)(d.row_off + n0 + n) * d.ldd + d.k_off + k0 + 8 * c) = o; }
    asm volatile("s_waitcnt lgkmcnt(0)" ::: "memory");
}
constexpr int NWD = 21;
__device__ __forceinline__ WDesc wdesc(const Args& a, int id) {
    unsigned char* ws = a.ws; WDesc d; d.mu = nullptr; d.mode = 0; d.perm = 0; d.k_off = 0; d.row_off = 0;
    const float* mu = a.in[I_MU];
    switch (id) {
    case 0:  d.W = a.in[I_WR]; d.ldw = D; d.Ksrc = D; d.Nsrc = D; d.dst = (bf16_t*)(ws + WT_G1); d.ldd = D; d.row_off = 0; break;
    case 1:  d.W = a.in[I_WK]; d.ldw = D; d.Ksrc = D; d.Nsrc = D; d.dst = (bf16_t*)(ws + WT_G1); d.ldd = D; d.row_off = 1024; break;
    case 2:  d.W = a.in[I_WV]; d.ldw = D; d.Ksrc = D; d.Nsrc = D; d.dst = (bf16_t*)(ws + WT_G1); d.ldd = D; d.row_off = 2048; break;
    case 3:  d.W = a.in[I_W1]; d.ldw = 64; d.Ksrc = D; d.Nsrc = 64; d.dst = (bf16_t*)(ws + WT_G1); d.ldd = D; d.row_off = 3072; d.mu = mu + 1 * D; d.mode = 1; break;
    case 4:  d.W = a.in[I_A1]; d.ldw = 64; d.Ksrc = D; d.Nsrc = 64; d.dst = (bf16_t*)(ws + WT_G1); d.ldd = D; d.row_off = 3136; d.mu = mu + 4 * D; d.mode = 1; break;
    case 5:  d.W = a.in[I_G1]; d.ldw = 128; d.Ksrc = D; d.Nsrc = 128; d.dst = (bf16_t*)(ws + WT_G1); d.ldd = D; d.row_off = 3200; d.mu = mu + 5 * D; d.mode = 1; break;
    case 6:  d.W = a.in[I_W1]; d.ldw = 64; d.Ksrc = D; d.Nsrc = 64; d.dst = (bf16_t*)(ws + WT_G1); d.ldd = D; d.row_off = 3328; d.mu = mu + 1 * D; d.mode = 2; break;
    case 7:  d.W = a.in[I_A1]; d.ldw = 64; d.Ksrc = D; d.Nsrc = 64; d.dst = (bf16_t*)(ws + WT_G1); d.ldd = D; d.row_off = 3392; d.mu = mu + 4 * D; d.mode = 2; break;
    case 8:  d.W = a.in[I_G1]; d.ldw = 128; d.Ksrc = D; d.Nsrc = 128; d.dst = (bf16_t*)(ws + WT_G1); d.ldd = D; d.row_off = 3456; d.mu = mu + 5 * D; d.mode = 2; break;
    case 9:  d.W = a.in[I_WO]; d.ldw = D; d.Ksrc = D; d.Nsrc = D; d.dst = (bf16_t*)(ws + WT_O0); d.ldd = D; break;
    case 10: d.W = a.in[I_UP]; d.ldw = FF; d.Ksrc = D; d.Nsrc = FF; d.dst = (bf16_t*)(ws + WT_UP0); d.ldd = D; break;
    case 11: d.W = a.in[I_DN]; d.ldw = D; d.Ksrc = FF; d.Nsrc = D; d.dst = (bf16_t*)(ws + WT_DN0); d.ldd = FF; break;
    case 12: d.W = a.in[I_WQ]; d.ldw = D; d.Ksrc = D; d.Nsrc = D; d.dst = (bf16_t*)(ws + WT_QKV); d.ldd = D; d.row_off = 0; d.perm = 1; break;
    case 13: d.W = a.in[I_KVK]; d.ldw = 256; d.Ksrc = D; d.Nsrc = 256; d.dst = (bf16_t*)(ws + WT_QKV); d.ldd = D; d.row_off = 1024; d.perm = 1; break;
    case 14: d.W = a.in[I_KVV]; d.ldw = 256; d.Ksrc = D; d.Nsrc = 256; d.dst = (bf16_t*)(ws + WT_QKV); d.ldd = D; d.row_off = 1280; break;
    case 15: d.W = a.in[I_BWO]; d.ldw = D; d.Ksrc = D; d.Nsrc = D; d.dst = (bf16_t*)(ws + WT_O1); d.ldd = D; break;
    case 16: d.W = a.in[I_UP] + (size_t)D * FF; d.ldw = FF; d.Ksrc = D; d.Nsrc = FF; d.dst = (bf16_t*)(ws + WT_UP1); d.ldd = D; break;
    case 17: d.W = a.in[I_DN] + (size_t)D * FF; d.ldw = D; d.Ksrc = FF; d.Nsrc = D; d.dst = (bf16_t*)(ws + WT_DN1); d.ldd = FF; break;
    case 18: d.W = a.in[I_W2]; d.ldw = D; d.Ksrc = 64; d.Nsrc = D; d.dst = (bf16_t*)(ws + WT_L2); d.ldd = 256; d.row_off = 0; d.k_off = 0; break;
    case 19: d.W = a.in[I_A2]; d.ldw = D; d.Ksrc = 64; d.Nsrc = D; d.dst = (bf16_t*)(ws + WT_L2); d.ldd = 256; d.row_off = 1024; d.k_off = 64; break;
    default: d.W = a.in[I_G2]; d.ldw = D; d.Ksrc = 128; d.Nsrc = D; d.dst = (bf16_t*)(ws + WT_L2); d.ldd = 256; d.row_off = 2048; d.k_off = 128; break;
    }
    return d;
}
__device__ __forceinline__ void p0_prologue(const Frame& F, const Args& a) {
    const int gw = F.vcu * NWAVES + F.wave, NGW = F.G * NWAVES, lane = F.lane;
    unsigned char* ws = F.ws;
    {
        u32x4* z = (u32x4*)(ws + WT_L2); const int nvec = N_L2 * 256 * 2 / 16;
        for (int i = gw * 64 + lane; i < nvec; i += NGW * 64) { const int row = i >> 5, k = (i & 31) * 8; const int blk = row >> 10;
            const bool nz = (blk == 0 && k < 64) || (blk == 1 && k >= 64 && k < 128) || (blk == 2 && k >= 128);
            if (!nz) z[i] = (u32x4){0u, 0u, 0u, 0u}; }
    }
    {
        LAS float* scr = (LAS float*)(F.lds + F.wave * 16384);
        int base = 0;
        for (int id = 0; id < NWD; ++id) {
            const WDesc d = wdesc(a, id);
            const int nit = (d.Ksrc / 64) * (d.Nsrc / 32);
            int first = (gw - base % NGW + NGW) % NGW;
            for (int it = first; it < nit; it += NGW) p0_transpose_item(d, scr, it, lane);
            base += nit;
        }
    }
    {
        float* ct = (float*)(ws + WS_ROPE);
        for (int i = gw * 64 + lane; i < LTOT * 32; i += NGW * 64) { const int p = i >> 5, j = i & 31;
            const float inv = 1.0f / powf(10000.0f, (float)j * (1.0f / 32.0f)); const float ang = (float)p * inv;
            ct[i] = cosf(ang); ct[LTOT * 32 + i] = sinf(ang); }
    }
    {
        const float* x = a.in[I_X]; const float* meta = a.in[I_META]; const float* mu = a.in[I_MU];
        for (int m = gw; m < MR; m += NGW) {
            const float* xr_ = m < M ? x + (size_t)m * D : meta + (size_t)(m - M) * D;
            const float* xp_ = m < M ? ((m & (SEQ - 1)) ? xr_ - D : meta + 15 * D) : (m > M ? xr_ - D : nullptr);
            const int xbr = xb_row(m);
#pragma unroll
            for (int j = 0; j < 4; ++j) {
                const int c = 4 * lane + 256 * j;
                const f32x4 xv = *(const f32x4*)(xr_ + c); const f32x4 pv = xp_ ? *(const f32x4*)(xp_ + c) : (f32x4){0.f, 0.f, 0.f, 0.f};
                const f32x4 dd = pv - xv;
                const f32x4 m0 = *(const f32x4*)(mu + 0 * D + c), m2 = *(const f32x4*)(mu + 2 * D + c), m3 = *(const f32x4*)(mu + 3 * D + c);
                const f32x4 r = xv + dd * m0, k = xv + dd * m2, v = xv + dd * m3;
                *(u32x2*)((bf16_t*)(ws + B_XR) + (size_t)m * D + c) = (u32x2){pk2(r.x, r.y), pk2(r.z, r.w)};
                *(u32x2*)((bf16_t*)(ws + B_XK) + (size_t)m * D + c) = (u32x2){pk2(k.x, k.y), pk2(k.z, k.w)};
                *(u32x2*)((bf16_t*)(ws + B_XV) + (size_t)m * D + c) = (u32x2){pk2(v.x, v.y), pk2(v.z, v.w)};
                *(u32x2*)((bf16_t*)(ws + B_XB) + (size_t)xbr * D + c) = (u32x2){pk2(xv.x, xv.y), pk2(xv.z, xv.w)};
                if ((m & (SEQ - 1)) == 0) *(u32x2*)((bf16_t*)(ws + B_XB) + (size_t)(xbr - 1) * D + c) = (u32x2){pk2(pv.x, pv.y), pk2(pv.z, pv.w)};
            }
        }
    }
}

__device__ __forceinline__ void lora_combine(const Frame& F) {
    const bf16_t* lp = (const bf16_t*)(F.dout + DO_LP); bf16_t* la = (bf16_t*)(F.dout + DO_LA);
    const int nvec = MR * 32;
    for (int i = (F.vcu * NTHREADS + F.tid); i < nvec; i += F.G * NTHREADS) {
        const int m = i >> 5, c = (i & 31) * 8;
        f32x4 a0, a1, b0, b1; unpack8(*(const u32x4*)(lp + (size_t)m * 512 + c), a0, a1); unpack8(*(const u32x4*)(lp + (size_t)m * 512 + 256 + c), b0, b1);
        a0 += b0; a1 += b1;
        if (c < 64) {
#pragma unroll
            for (int j = 0; j < 4; ++j) { a0[j] = tanhf(a0[j]); a1[j] = tanhf(a1[j]); }
        } else if (c >= 128) {
#pragma unroll
            for (int j = 0; j < 4; ++j) { a0[j] = sigmoidf_(a0[j]); a1[j] = sigmoidf_(a1[j]); }
        }
        *(u32x4*)(la + (size_t)m * 256 + c) = pack8(a0, a1);
    }
}

__device__ __forceinline__ void ln_phase(const Frame& F, const float* g, const float* b, float* final_out) {
    const int gw = F.vcu * NWAVES + F.wave, NGW = F.G * NWAVES, lane = F.lane;
    const int nrows = final_out ? M : MR;
    for (int m = gw; m < nrows; m += NGW) {
        float* row = (float*)(F.ws + B_RS) + (size_t)m * D;
        f32x4 v[4]; float s = 0.f;
#pragma unroll
        for (int j = 0; j < 4; ++j) { v[j] = *(const f32x4*)(row + 4 * lane + 256 * j); s += (v[j].x + v[j].y) + (v[j].z + v[j].w); }
        const float mean = wave_sum(s) * (1.f / D); float s2 = 0.f;
#pragma unroll
        for (int j = 0; j < 4; ++j) { v[j] = v[j] - mean; s2 += (v[j].x * v[j].x + v[j].y * v[j].y) + (v[j].z * v[j].z + v[j].w * v[j].w); }
        const float rstd = 1.f / sqrtf(wave_sum(s2) * (1.f / D) + LN_EPS);
#pragma unroll
        for (int j = 0; j < 4; ++j) {
            const int c = 4 * lane + 256 * j;
            const f32x4 o = v[j] * rstd * *(const f32x4*)(g + c) + *(const f32x4*)(b + c);
            if (final_out) *(f32x4*)(final_out + (size_t)m * D + c) = o;
            else { *(f32x4*)(row + c) = o; *(u32x2*)((bf16_t*)(F.ws + B_HB) + (size_t)m * D + c) = (u32x2){pk2(o.x, o.y), pk2(o.z, o.w)}; }
        }
    }
}

constexpr int SC_NCH = 1 + SEQ / 16;
constexpr int SC_SLOT = 18944, SC_NSLOT = 5;
constexpr int SO_AT = 0, SO_RT = 2048, SO_BT = 4096, SO_KT = 6144, SO_VROW = 8192, SO_GROW = 10240, SO_GAK = 12288, SO_GRB = 12800, SO_GRK = 13312, SO_TT = 13824,
              SO_GAM = 14336, SO_BON = 14592, SO_Y = 14848;
constexpr int SC_PAR = SC_SLOT * SC_NSLOT;
static_assert(SC_PAR + 1024 <= LDSCTL_OFF, "scan LDS map");
__device__ __forceinline__ s16x4 pack4(f32x4 x) { u32x2 w; w.x = pk2(x.x, x.y); w.y = pk2(x.z, x.w); return __builtin_bit_cast(s16x4, w); }
__device__ __forceinline__ f32x4 mfma16(s16x4 a, s16x4 b, f32x4 c) { return __builtin_amdgcn_mfma_f32_16x16x16bf16_1k(a, b, c, 0, 0, 0); }
__device__ __forceinline__ f32x4 mfma32(bf16x8 a, bf16x8 b, f32x4 c) { return __builtin_amdgcn_mfma_f32_16x16x32_bf16(a, b, c, 0, 0, 0); }
__device__ __forceinline__ s16x4 lds_tr(LAS unsigned char* p) { return __builtin_bit_cast(s16x4, __builtin_amdgcn_ds_read_tr16_b64_v4i16((LAS s16x4*)p)); }
__device__ __forceinline__ int sc_row(int b, int c, int t) { return c == 0 ? M + t : b * SEQ + (c - 1) * 16 + t; }
struct ScPre { u32x4 r[2], k[2], v[2], a[2], g[2]; f32x4 ld[4]; };
struct ScMid { f32x4 an[4], bb[4], km[4], rr[4], ld[4]; };
struct ScCtx { LAS unsigned char* L; const bf16_t *Rg, *Kg, *Vg, *Ag, *Gg; const float* LDg; bf16_t* Og; int b, h, lane; };
#define SC_BAR() do { asm volatile("s_waitcnt lgkmcnt(0)" ::: "memory"); __builtin_amdgcn_s_barrier(); asm volatile("" ::: "memory"); } while (0)

__device__ __forceinline__ void sc_load(const ScCtx& C, ScPre& P, int c) {
    const size_t o = (size_t)sc_row(C.b, c, C.lane & 15) * D + C.h * 64 + 16 * (C.lane >> 4);
    P.r[0] = *(const u32x4*)(C.Rg + o); P.r[1] = *(const u32x4*)(C.Rg + o + 8); P.k[0] = *(const u32x4*)(C.Kg + o); P.k[1] = *(const u32x4*)(C.Kg + o + 8);
    P.v[0] = *(const u32x4*)(C.Vg + o); P.v[1] = *(const u32x4*)(C.Vg + o + 8); P.a[0] = *(const u32x4*)(C.Ag + o); P.a[1] = *(const u32x4*)(C.Ag + o + 8);
    P.g[0] = *(const u32x4*)(C.Gg + o); P.g[1] = *(const u32x4*)(C.Gg + o + 8);
    P.ld[0] = *(const f32x4*)(C.LDg + o); P.ld[1] = *(const f32x4*)(C.LDg + o + 4); P.ld[2] = *(const f32x4*)(C.LDg + o + 8); P.ld[3] = *(const f32x4*)(C.LDg + o + 12);
}
__device__ __forceinline__ void sc_stepA(const ScCtx& C, const ScPre& P, ScMid& Q, int c, bool valid) {
    const int t = C.lane & 15, cg = C.lane >> 4;
    LAS unsigned char* sb = C.L + (c % SC_NSLOT) * SC_SLOT;
    const LAS f32x4* par = (const LAS f32x4*)(C.L + SC_PAR) + 4 * cg;
    f32x4 kk[4], aa[4];
    unpack8(P.r[0], Q.rr[0], Q.rr[1]); unpack8(P.r[1], Q.rr[2], Q.rr[3]); unpack8(P.k[0], kk[0], kk[1]); unpack8(P.k[1], kk[2], kk[3]); unpack8(P.a[0], aa[0], aa[1]); unpack8(P.a[1], aa[2], aa[3]);
    float ss = 0.f, bon = 0.f;
#pragma unroll
    for (int i = 0; i < 4; ++i) { const f32x4 kkp = par[i], kap = par[16 + i], rkp = par[32 + i];
        Q.an[i] = kk[i] * kkp; ss += (Q.an[i].x * Q.an[i].x + Q.an[i].y * Q.an[i].y) + (Q.an[i].z * Q.an[i].z + Q.an[i].w * Q.an[i].w);
        Q.km[i] = kk[i] * (1.0f + (aa[i] - 1.0f) * kap); const f32x4 pb = Q.rr[i] * Q.km[i] * rkp; bon += (pb.x + pb.y) + (pb.z + pb.w); Q.ld[i] = P.ld[i]; }
    ss += __shfl_xor(ss, 16); ss += __shfl_xor(ss, 32); bon += __shfl_xor(bon, 16); bon += __shfl_xor(bon, 32);
    const float inv = 1.0f / fmaxf(sqrtf(ss), 1e-12f);
#pragma unroll
    for (int i = 0; i < 4; ++i) { const f32x4 qn = Q.an[i] * inv; Q.an[i] = -qn; Q.bb[i] = qn * aa[i]; }
    if (valid) {
        const int ro = t * 128 + cg * 32;
        *(LAS u32x4*)(sb + SO_VROW + ro) = P.v[0]; *(LAS u32x4*)(sb + SO_VROW + ro + 16) = P.v[1];
        *(LAS u32x4*)(sb + SO_GROW + ro) = P.g[0]; *(LAS u32x4*)(sb + SO_GROW + ro + 16) = P.g[1];
        if (cg == 0) *(LAS float*)(sb + SO_BON + t * 4) = bon;
    }
}
template <int CTRL> __device__ __forceinline__ float dpp0(float x) { return __builtin_bit_cast(float, __builtin_amdgcn_update_dpp(0, __builtin_bit_cast(int, x), CTRL, 0xF, 0xF, true)); }
__device__ __forceinline__ void sc_stepB(const ScCtx& C, const ScMid& Q, int c, bool valid) {
    const int t = C.lane & 15, cg = C.lane >> 4;
    LAS unsigned char* sb = C.L + (c % SC_NSLOT) * SC_SLOT;
    f32x4 at[4], rt[4], bt[4], kt[4], gam[4];
#pragma unroll
    for (int i = 0; i < 4; ++i)
#pragma unroll
        for (int e = 0; e < 4; ++e) {
            float x = Q.ld[i][e];
            x += dpp0<0x111>(x); x += dpp0<0x112>(x); x += dpp0<0x114>(x); x += dpp0<0x118>(x);
            const float g = __expf(x), ig = __builtin_amdgcn_rcpf(g);
            const float gp = __builtin_bit_cast(float, __builtin_amdgcn_update_dpp(0x3f800000, __builtin_bit_cast(int, g), 0x111, 0xF, 0xF, false));
            at[i][e] = Q.an[i][e] * gp; rt[i][e] = Q.rr[i][e] * g; bt[i][e] = Q.bb[i][e] * ig; kt[i][e] = Q.km[i][e] * ig; gam[i][e] = g;
        }
    if (valid) {
        const int ro = t * 128 + cg * 32;
        *(LAS u32x4*)(sb + SO_AT + ro) = pack8(at[0], at[1]); *(LAS u32x4*)(sb + SO_AT + ro + 16) = pack8(at[2], at[3]);
        *(LAS u32x4*)(sb + SO_RT + ro) = pack8(rt[0], rt[1]); *(LAS u32x4*)(sb + SO_RT + ro + 16) = pack8(rt[2], rt[3]);
        *(LAS u32x4*)(sb + SO_BT + ro) = pack8(bt[0], bt[1]); *(LAS u32x4*)(sb + SO_BT + ro + 16) = pack8(bt[2], bt[3]);
        *(LAS u32x4*)(sb + SO_KT + ro) = pack8(kt[0], kt[1]); *(LAS u32x4*)(sb + SO_KT + ro + 16) = pack8(kt[2], kt[3]);
        if (t == 15) {
#pragma unroll
            for (int i = 0; i < 4; ++i) *(LAS f32x4*)(sb + SO_GAM + cg * 64 + 16 * i) = gam[i];
        }
    }
}
__device__ __forceinline__ void sc_stepG(const ScCtx& C, int c) {
    LAS unsigned char* sb = C.L + (c % SC_NSLOT) * SC_SLOT;
    const int l15 = C.lane & 15, kg = C.lane >> 4;
    bf16x8 aF[2], rF[2], bF[2], kF[2];
#pragma unroll
    for (int ks = 0; ks < 2; ++ks) { const int o = l15 * 128 + (32 * ks + 8 * kg) * 2;
        aF[ks] = *(const LAS bf16x8*)(sb + SO_AT + o); rF[ks] = *(const LAS bf16x8*)(sb + SO_RT + o); bF[ks] = *(const LAS bf16x8*)(sb + SO_BT + o); kF[ks] = *(const LAS bf16x8*)(sb + SO_KT + o); }
    const f32x4 z = {0.f, 0.f, 0.f, 0.f};
    f32x4 LT = mfma32(bF[1], aF[1], mfma32(bF[0], aF[0], z));
    f32x4 LN = mfma32(aF[1], bF[1], mfma32(aF[0], bF[0], z));
    f32x4 GAK = mfma32(kF[1], aF[1], mfma32(kF[0], aF[0], z));
    f32x4 GRB = mfma32(bF[1], rF[1], mfma32(bF[0], rF[0], z));
    f32x4 GRK = mfma32(kF[1], rF[1], mfma32(kF[0], rF[0], z));
    f32x4 T1T;
#pragma unroll
    for (int r = 0; r < 4; ++r) { const int idx = 4 * kg + r;
        LT[r] = idx < l15 ? LT[r] : 0.f; LN[r] = idx > l15 ? LN[r] : 0.f; GAK[r] = idx < l15 ? GAK[r] : 0.f; GRB[r] = idx <= l15 ? GRB[r] : 0.f; GRK[r] = idx <= l15 ? GRK[r] : 0.f;
        T1T[r] = LT[r] + (idx == l15 ? 1.0f : 0.f); }
    *(LAS s16x4*)(sb + SO_GAK + l15 * 32 + kg * 8) = pack4(GAK); *(LAS s16x4*)(sb + SO_GRB + l15 * 32 + kg * 8) = pack4(GRB); *(LAS s16x4*)(sb + SO_GRK + l15 * 32 + kg * 8) = pack4(GRK);
    const s16x4 LTb = pack4(LT), LNb = pack4(LN);
    const f32x4 L2N = mfma16(LTb, LNb, z), L2T = mfma16(LNb, LTb, z);
    const s16x4 L2Nb = pack4(L2N), L2Tb = pack4(L2T);
    const f32x4 T2T = mfma16(L2Nb, pack4(T1T), T1T);
    const f32x4 L4N = mfma16(L2Tb, L2Nb, z), L4T = mfma16(L2Nb, L2Tb, z);
    const s16x4 L4Nb = pack4(L4N);
    const f32x4 T4T = mfma16(L4Nb, pack4(T2T), T2T);
    const f32x4 L8N = mfma16(pack4(L4T), L4Nb, z);
    const f32x4 T8T = mfma16(pack4(L8N), pack4(T4T), T4T);
    *(LAS s16x4*)(sb + SO_TT + l15 * 32 + kg * 8) = pack4(T8T);
}
template <int PGP> __device__ __forceinline__ void sc_pg_loop(const ScCtx& C) {
    ScPre P; ScMid Q; sc_load(C, P, PGP);
#pragma unroll
    for (int i = 0; i < 4; ++i) { Q.an[i] = Q.bb[i] = Q.km[i] = Q.rr[i] = Q.ld[i] = (f32x4){0.f, 0.f, 0.f, 0.f}; }
    for (int it = 0; it < SC_NCH + 4; it += 3) {
#pragma unroll
        for (int u = 0; u < 3; ++u) {
            if (u == PGP) { const int c = it + u; sc_stepA(C, P, Q, c, c < SC_NCH); const int cn = c + 3 < SC_NCH ? c + 3 : SC_NCH - 1; sc_load(C, P, cn); }
            else if (u == (PGP + 1) % 3) { const int c = it + u - 1; sc_stepB(C, Q, c < 0 ? 0 : c, c >= 0 && c < SC_NCH); }
            else { const int c = it + u - 2; if (c >= 0 && c < SC_NCH) sc_stepG(C, c); }
            SC_BAR();
        }
    }
}
__device__ __forceinline__ void sc_consumer_loop(const ScCtx& C, int wave) {
    const int lane = C.lane, l15 = lane & 15, kg = lane >> 4, i0 = 16 * wave;
    const int tro = (4 * kg + (l15 >> 2)) * 128 + 8 * (l15 & 3);
    f32x4 St[4];
#pragma unroll
    for (int q = 0; q < 4; ++q) St[q] = (f32x4){0.f, 0.f, 0.f, 0.f};
    for (int s = -3; s <= SC_NCH; ++s) {
        if (s >= 0 && s < SC_NCH) {
            LAS unsigned char* sb = C.L + (s % SC_NSLOT) * SC_SLOT;
            s16x4 aX[4], rX[4], bh[4], kh[4]; f32x4 gam[4];
#pragma unroll
            for (int jt = 0; jt < 4; ++jt) {
                aX[jt] = *(const LAS s16x4*)(sb + SO_AT + l15 * 128 + jt * 32 + kg * 8);
                rX[jt] = *(const LAS s16x4*)(sb + SO_RT + l15 * 128 + jt * 32 + kg * 8);
                bh[jt] = lds_tr(sb + SO_BT + tro + jt * 32);
                kh[jt] = lds_tr(sb + SO_KT + tro + jt * 32);
                gam[jt] = *(const LAS f32x4*)(sb + SO_GAM + (16 * jt + 4 * kg) * 4);
            }
            const s16x4 gak = *(const LAS s16x4*)(sb + SO_GAK + l15 * 32 + kg * 8), grb = *(const LAS s16x4*)(sb + SO_GRB + l15 * 32 + kg * 8);
            const s16x4 grk = *(const LAS s16x4*)(sb + SO_GRK + l15 * 32 + kg * 8), ttf = *(const LAS s16x4*)(sb + SO_TT + l15 * 32 + kg * 8);
            const s16x4 vF = lds_tr(sb + SO_VROW + tro + i0 * 2);
            f32x4 X = {0.f, 0.f, 0.f, 0.f}, Y = {0.f, 0.f, 0.f, 0.f};
#pragma unroll
            for (int jt = 0; jt < 4; ++jt) { const s16x4 sbf = pack4(St[jt]); X = mfma16(aX[jt], sbf, X); Y = mfma16(rX[jt], sbf, Y); }
            X = mfma16(gak, vF, X);
            const f32x4 U = mfma16(ttf, pack4(X), (f32x4){0.f, 0.f, 0.f, 0.f});
            const s16x4 Ub = pack4(U);
            Y = mfma16(grb, Ub, Y); Y = mfma16(grk, vF, Y);
#pragma unroll
            for (int jt = 0; jt < 4; ++jt) { St[jt] = mfma16(bh[jt], Ub, St[jt]); St[jt] = mfma16(kh[jt], vF, St[jt]); St[jt] = St[jt] * gam[jt]; }
#pragma unroll
            for (int r = 0; r < 4; ++r) *(LAS float*)(sb + SO_Y + ((4 * kg + r) * 64 + i0 + l15) * 4) = Y[r];
        }
        SC_BAR();
    }
}
__device__ __forceinline__ void sc_post_loop(const ScCtx& C, const float* gnw_g, const float* gnb_g) {
    const int tq = C.lane >> 2, cg = C.lane & 3;
    f32x4 gnw[4], gnb[4];
#pragma unroll
    for (int q = 0; q < 4; ++q) { gnw[q] = *(const f32x4*)(gnw_g + C.h * 64 + 16 * cg + 4 * q); gnb[q] = *(const f32x4*)(gnb_g + C.h * 64 + 16 * cg + 4 * q); }
    for (int s = -3; s <= SC_NCH; ++s) {
        const int cp = s - 1;
        if (cp >= 0 && cp < SC_NCH && (cp > 0 || C.b == 0)) {
            LAS unsigned char* sb = C.L + (cp % SC_NSLOT) * SC_SLOT;
            f32x4 y[4], vv[4], gg[4];
#pragma unroll
            for (int i = 0; i < 4; ++i) y[i] = *(const LAS f32x4*)(sb + SO_Y + tq * 256 + cg * 64 + 16 * i);
            unpack8(*(const LAS u32x4*)(sb + SO_VROW + tq * 128 + cg * 32), vv[0], vv[1]); unpack8(*(const LAS u32x4*)(sb + SO_VROW + tq * 128 + cg * 32 + 16), vv[2], vv[3]);
            unpack8(*(const LAS u32x4*)(sb + SO_GROW + tq * 128 + cg * 32), gg[0], gg[1]); unpack8(*(const LAS u32x4*)(sb + SO_GROW + tq * 128 + cg * 32 + 16), gg[2], gg[3]);
            const float bon = *(const LAS float*)(sb + SO_BON + tq * 4);
            float sm = 0.f;
#pragma unroll
            for (int i = 0; i < 4; ++i) sm += (y[i].x + y[i].y) + (y[i].z + y[i].w);
            sm += dppf<0xB1>(sm); sm += dppf<0x4E>(sm);
            const float mean = sm * (1.0f / 64.0f); float s2 = 0.f;
#pragma unroll
            for (int i = 0; i < 4; ++i) { y[i] = y[i] - mean; s2 += (y[i].x * y[i].x + y[i].y * y[i].y) + (y[i].z * y[i].z + y[i].w * y[i].w); }
            s2 += dppf<0xB1>(s2); s2 += dppf<0x4E>(s2);
            const float rstd = __builtin_amdgcn_rsqf(s2 * (1.0f / 64.0f) + GN_EPS);
            f32x4 o[4];
#pragma unroll
            for (int i = 0; i < 4; ++i) o[i] = (y[i] * rstd * gnw[i] + gnb[i] + bon * vv[i]) * gg[i];
            bf16_t* op = C.Og + (size_t)sc_row(C.b, cp, tq) * D + C.h * 64 + 16 * cg;
            *(u32x4*)op = pack8(o[0], o[1]); *(u32x4*)(op + 8) = pack8(o[2], o[3]);
        }
        SC_BAR();
    }
}
__device__ __forceinline__ void scan_phase(const Frame& F, const Args& a) {
    if (F.vcu >= NB * NH) return;
    ScCtx C; C.L = F.lds; C.b = F.vcu >> 4; C.h = F.vcu & 15; C.lane = F.lane;
    C.Rg = (const bf16_t*)(F.ws + B_R); C.Kg = (const bf16_t*)(F.ws + B_K); C.Vg = (const bf16_t*)(F.ws + B_V);
    C.Ag = (const bf16_t*)(F.ws + B_A); C.Gg = (const bf16_t*)(F.ws + B_G); C.LDg = (const float*)(F.ws + B_LD); C.Og = (bf16_t*)(F.dout + DO_O);
    if (F.tid < 192) { const int w = F.tid >> 6, j = F.tid & 63; const float* src = w == 0 ? a.in[I_KK] : (w == 1 ? a.in[I_KA] : a.in[I_RK]); ((LAS float*)(C.L + SC_PAR))[w * 64 + j] = src[C.h * 64 + j]; }
    SC_BAR();
    const int wave = F.wave;
    if (wave < 4) sc_consumer_loop(C, wave);
    else if (wave == 4) sc_pg_loop<0>(C);
    else if (wave == 5) sc_pg_loop<1>(C);
    else if (wave == 6) sc_pg_loop<2>(C);
    else sc_post_loop(C, a.in[I_GNW], a.in[I_GNB]);
}

__device__ __forceinline__ int kv_lds_off(int row, int ch) { return row * 128 + ((ch ^ (row & 7)) << 4); }
__device__ __forceinline__ int crow(int r, int hi) { return (r & 3) + 8 * (r >> 2) + 4 * hi; }
__device__ __forceinline__ void attn_phase(const Frame& F, const Args& a) {
    const int tid = F.tid, lane = F.lane, wid = F.wave, r32 = lane & 31, hi = lane >> 5;
    LAS unsigned char* sKt = F.lds; LAS unsigned char* sVt = F.lds + 24576;
    const bf16_t* Qg = (const bf16_t*)(F.ws + B_Q); const bf16_t* Kc = (const bf16_t*)(F.ws + B_KC); const bf16_t* Vc = (const bf16_t*)(F.ws + B_VC);
    bf16_t* Og = (bf16_t*)(F.ws + B_AO);
    const int g = wid >> 1, half = wid & 1;
    for (int u = F.vcu; u < NB * NKV * (SEQ / 64); u += F.G) {
        const int qt = u & 63, kvh = (u >> 6) & 3, b = u >> 8;
        const int t0 = qt * 64, p0 = t0 - 112;
        const int head = kvh * 4 + g;
#pragma unroll
        for (int i = 0; i < 3; ++i) {
            const int idx = tid + 512 * i, row = idx >> 3, ch = idx & 7, p = p0 + row;
            u32x4 kv = {0u, 0u, 0u, 0u}, vv = {0u, 0u, 0u, 0u};
            if (p >= 0) { const size_t o = (size_t)(b * LTOT + p) * 256 + kvh * 64 + ch * 8; kv = *(const u32x4*)(Kc + o); vv = *(const u32x4*)(Vc + o); }
            *(LAS u32x4*)(sKt + kv_lds_off(row, ch)) = kv; *(LAS u32x4*)(sVt + kv_lds_off(row, ch)) = vv;
        }
        const int mq = b * SEQ + t0 + half * 32 + r32;
        bf16x8 qf[4];
#pragma unroll
        for (int ds = 0; ds < 4; ++ds) qf[ds] = *(const bf16x8*)(Qg + (size_t)mq * D + head * 64 + ds * 16 + hi * 8);
        __syncthreads();
        f32x16 p[5];
#pragma unroll
        for (int i = 0; i < 5; ++i) {
            p[i] = (f32x16){0.f, 0.f, 0.f, 0.f, 0.f, 0.f, 0.f, 0.f, 0.f, 0.f, 0.f, 0.f, 0.f, 0.f, 0.f, 0.f};
            const int krow = (half + i) * 32 + r32;
#pragma unroll
            for (int ds = 0; ds < 4; ++ds) {
                const bf16x8 kf = *(const LAS bf16x8*)(sKt + kv_lds_off(krow, 2 * ds + hi));
                p[i] = __builtin_amdgcn_mfma_f32_32x32x16_bf16(kf, qf[ds], p[i], 0, 0, 0);
            }
        }
        const int pq = t0 + NMETA + half * 32 + r32;
        const float sink = a.in[I_SINK][head];
        float mx = sink;
#pragma unroll
        for (int i = 0; i < 5; ++i)
#pragma unroll
            for (int r = 0; r < 16; ++r) { const int pk = p0 + (half + i) * 32 + crow(r, hi); const bool ok = (pk >= 0) && (pk <= pq) && (pk + 127 >= pq);
                p[i][r] = ok ? p[i][r] : -INFINITY; mx = fmaxf(mx, p[i][r]); }
        mx = fmaxf(mx, __shfl_xor(mx, 32));
        float den = 0.f;
#pragma unroll
        for (int i = 0; i < 5; ++i)
#pragma unroll
            for (int r = 0; r < 16; ++r) { const float e = __expf(p[i][r] - mx); p[i][r] = e; den += e; }
        den += __shfl_xor(den, 32);
        den += __expf(sink - mx);
        const float rden = 1.0f / den;
        f32x16 o[2];
        o[0] = (f32x16){0.f, 0.f, 0.f, 0.f, 0.f, 0.f, 0.f, 0.f, 0.f, 0.f, 0.f, 0.f, 0.f, 0.f, 0.f, 0.f}; o[1] = o[0];
        const int grp = lane >> 4, li = lane & 15, tq = li >> 2, tp = li & 3;
#pragma unroll
        for (int i = 0; i < 5; ++i)
#pragma unroll
            for (int s = 0; s < 2; ++s) {
                u32x4 pw; pw.x = pk2(p[i][8 * s + 0], p[i][8 * s + 1]); pw.y = pk2(p[i][8 * s + 2], p[i][8 * s + 3]); pw.z = pk2(p[i][8 * s + 4], p[i][8 * s + 5]); pw.w = pk2(p[i][8 * s + 6], p[i][8 * s + 7]);
                const bf16x8 pb = __builtin_bit_cast(bf16x8, pw);
                const int kvb = (half + i) * 32 + 16 * s + 4 * (grp >> 1) + tq;
#pragma unroll
                for (int dt = 0; dt < 2; ++dt) {
                    const int col = dt * 32 + 16 * (grp & 1) + 4 * tp;
                    const int o1 = kv_lds_off(kvb, col >> 3) + ((col >> 2) & 1) * 8, o2 = kv_lds_off(kvb + 8, col >> 3) + ((col >> 2) & 1) * 8;
                    const s16x4 v1 = __builtin_bit_cast(s16x4, __builtin_amdgcn_ds_read_tr16_b64_v4i16((LAS s16x4*)(sVt + o1)));
                    const s16x4 v2 = __builtin_bit_cast(s16x4, __builtin_amdgcn_ds_read_tr16_b64_v4i16((LAS s16x4*)(sVt + o2)));
                    const bf16x8 va = (bf16x8){v1[0], v1[1], v1[2], v1[3], v2[0], v2[1], v2[2], v2[3]};
                    o[dt] = __builtin_amdgcn_mfma_f32_32x32x16_bf16(va, pb, o[dt], 0, 0, 0);
                }
            }
        bf16_t* orow = Og + (size_t)mq * D + head * 64;
#pragma unroll
        for (int dt = 0; dt < 2; ++dt)
#pragma unroll
            for (int r4 = 0; r4 < 4; ++r4) {
                const int d = dt * 32 + 8 * r4 + 4 * hi;
                *(u32x2*)(orow + d) = (u32x2){pk2(o[dt][4 * r4] * rden, o[dt][4 * r4 + 1] * rden), pk2(o[dt][4 * r4 + 2] * rden, o[dt][4 * r4 + 3] * rden)};
            }
        __syncthreads();
    }
}

constexpr int N_PHASES = 17;
__global__ void __launch_bounds__(NTHREADS, 2) yoco_fwd(Args args) {
    extern __shared__ __attribute__((aligned(16))) unsigned char lds[];
    Frame F;
    F.lds = (LAS unsigned char*)lds;
    F.tid = threadIdx.x; F.lane = F.tid & 63; F.wave = __builtin_amdgcn_readfirstlane(F.tid >> 6);
    F.G = gridDim.x; { const int bx = blockIdx.x; F.vcu = (F.G % 8 == 0) ? (bx % 8) * (F.G / 8) + bx / 8 : bx; }
    F.ws = args.ws; F.dout = (unsigned char*)args.out;
    volatile LAS unsigned* MISC = (volatile LAS unsigned*)(F.lds + MISC_OFF);
    for (int u = F.tid; u < (LDS_BYTES - LDSCTL_OFF) / 4; u += NTHREADS) ((LAS unsigned*)(F.lds + LDSCTL_OFF))[u] = 0u;
    __syncthreads();
    XcdBarrier bar; bar.bar = (unsigned*)(F.ws + WS_CTL) + CW_BAR; bar.x = 0; bar.st = nullptr;
    const int lo = args.ph_lo, hi = args.ph_hi;
    if (hi - lo > 1) bar = xcd_barrier_post((unsigned*)(F.ws + WS_CTL) + CW_BAR, MISC + 8);
#define IN(k) (lo <= (k) && (k) < hi)
#define SEAM(k) do { if (IN(k) && IN((k) + 1)) xcd_barrier(bar); } while (0)
    const int bx = blockIdx.x;
    unsigned char* ws = F.ws;
    const float* lng = args.in[I_LNG]; const float* lnb = args.in[I_LNB];

    if (IN(0)) { p0_prologue(F, args); } SEAM(0);
    if (IN(1)) {
        pg8::StaticOrder S; S.init(M, N_G1, F.G, bx);
        const AMapG1 AM{(const char*)ws}; const pg8::Epi8<EpiG1> E{{ws, F.dout}};
        pg8::gemm_phase(F.lds, AM, (const bf16_t*)(ws + WT_G1), D, S, E);
        meta_gemm(F.lds, AM, (const bf16_t*)(ws + WT_G1), N_G1, D, F.vcu, F.G, E.f);
    } SEAM(1);
    if (IN(2)) { lora_combine(F); } SEAM(2);
    if (IN(3)) {
        pg8::StaticOrder S; S.init(M, N_L2, F.G, bx);
        const AMapPlain AM{(const char*)(F.dout + DO_LA), (size_t)256 * 256 * 2}; const pg8::Epi8<EpiL2> E{{ws, args.in[I_W0], args.in[I_A0]}};
        pg8::gemm_phase(F.lds, AM, (const bf16_t*)(ws + WT_L2), 256, S, E);
        meta_gemm(F.lds, AM, (const bf16_t*)(ws + WT_L2), N_L2, 256, F.vcu, F.G, E.f);
    } SEAM(3);
    if (IN(4)) { scan_phase(F, args); } SEAM(4);
    if (IN(5)) {
        pg8::StaticOrder S; S.init(M, D, F.G, bx);
        const AMapPlain AM{(const char*)(F.dout + DO_O), (size_t)256 * D * 2}; const pg8::Epi8<EpiRes> E{{ws, args.in[I_X], args.in[I_META]}};
        pg8::gemm_phase(F.lds, AM, (const bf16_t*)(ws + WT_O0), D, S, E);
        meta_gemm(F.lds, AM, (const bf16_t*)(ws + WT_O0), D, D, F.vcu, F.G, E.f);
    } SEAM(5);
    if (IN(6)) { ln_phase(F, lng + 0 * D, lnb + 0 * D, nullptr); } SEAM(6);
    if (IN(7)) {
        pg8::StaticOrder S; S.init(M, FF, F.G, bx);
        const AMapPlain AM{(const char*)(ws + B_HB), (size_t)256 * D * 2}; const pg8::Epi8<EpiUp> E{{ws}};
        pg8::gemm_phase(F.lds, AM, (const bf16_t*)(ws + WT_UP0), D, S, E);
        meta_gemm(F.lds, AM, (const bf16_t*)(ws + WT_UP0), FF, D, F.vcu, F.G, E.f);
    } SEAM(7);
    if (IN(8)) {
        pg8::StaticOrder S; S.init(M, D, F.G, bx);
        const AMapPlain AM{(const char*)(ws + B_U), (size_t)256 * FF * 2}; const pg8::Epi8<EpiRes> E{{ws, nullptr, nullptr}};
        pg8::gemm_phase(F.lds, AM, (const bf16_t*)(ws + WT_DN0), FF, S, E);
        meta_gemm(F.lds, AM, (const bf16_t*)(ws + WT_DN0), D, FF, F.vcu, F.G, E.f);
    } SEAM(8);
    if (IN(9)) { ln_phase(F, lng + 1 * D, lnb + 1 * D, nullptr); } SEAM(9);
    if (IN(10)) {
        pg8::StaticOrder S; S.init(M, N_QKV, F.G, bx);
        const AMapPlain AM{(const char*)(ws + B_HB), (size_t)256 * D * 2}; const pg8::Epi8<EpiQKV> E{{ws}};
        pg8::gemm_phase(F.lds, AM, (const bf16_t*)(ws + WT_QKV), D, S, E);
        meta_gemm(F.lds, AM, (const bf16_t*)(ws + WT_QKV), N_QKV, D, F.vcu, F.G, E.f, 1024 / 32);
    } SEAM(10);
    if (IN(11)) { attn_phase(F, args); } SEAM(11);
    if (IN(12)) {
        pg8::StaticOrder S; S.init(M, D, F.G, bx);
        const AMapPlain AM{(const char*)(ws + B_AO), (size_t)256 * D * 2}; const pg8::Epi8<EpiRes> E{{ws, nullptr, nullptr}};
        pg8::gemm_phase(F.lds, AM, (const bf16_t*)(ws + WT_O1), D, S, E);
    } SEAM(12);
    if (IN(13)) { ln_phase(F, lng + 2 * D, lnb + 2 * D, nullptr); } SEAM(13);
    if (IN(14)) {
        pg8::StaticOrder S; S.init(M, FF, F.G, bx);
        const AMapPlain AM{(const char*)(ws + B_HB), (size_t)256 * D * 2}; const pg8::Epi8<EpiUp> E{{ws}};
        pg8::gemm_phase(F.lds, AM, (const bf16_t*)(ws + WT_UP1), D, S, E);
    } SEAM(14);
    if (IN(15)) {
        pg8::StaticOrder S; S.init(M, D, F.G, bx);
        const AMapPlain AM{(const char*)(ws + B_U), (size_t)256 * FF * 2}; const pg8::Epi8<EpiRes> E{{ws, nullptr, nullptr}};
        pg8::gemm_phase(F.lds, AM, (const bf16_t*)(ws + WT_DN1), FF, S, E);
    } SEAM(15);
    if (IN(16)) { ln_phase(F, lng + 3 * D, lnb + 3 * D, args.out); }
#undef IN
#undef SEAM
}

extern "C" void kernel_launch(void* const* d_in, const int* in_sizes, int n_in, void* d_out, int out_size, void* d_ws, size_t ws_size, hipStream_t stream) {
    static int grid = 0;
    if (grid == 0) {
        if (n_in != 29 || in_sizes[0] != M * D || out_size != M * D || ws_size < WS_END) { fprintf(stderr, "kernel_launch: unexpected shapes (n_in %d, in0 %d, out %d, ws %zu)\n", n_in, n_in > 0 ? in_sizes[0] : -1, out_size, ws_size); grid = -1; return; }
        int dev = 0, cus = 0;
        if (hipGetDevice(&dev) != hipSuccess || hipDeviceGetAttribute(&cus, hipDeviceAttributeMultiprocessorCount, dev) != hipSuccess) { grid = -1; return; }
        if (hipFuncSetAttribute((const void*)yoco_fwd, hipFuncAttributeMaxDynamicSharedMemorySize, LDS_BYTES) != hipSuccess) { fprintf(stderr, "kernel_launch: hipFuncSetAttribute failed\n"); grid = -1; return; }
        (void)hipGetLastError();
        grid = cus;
    }
    if (grid < 0) return;
    if (hipMemsetAsync((char*)d_ws + WS_CTL, 0, CTL_ZERO_BYTES, stream) != hipSuccess) return;
    Args a{};
    for (int i = 0; i < 29; ++i) a.in[i] = (const float*)d_in[i];
    a.out = (float*)d_out; a.ws = (unsigned char*)d_ws;
#if MK_N_LAUNCHES == 1
    a.ph_lo = 0; a.ph_hi = N_PHASES;
    hipLaunchKernelGGL(yoco_fwd, dim3(grid), dim3(NTHREADS), LDS_BYTES, stream, a);
#else
    for (int p = 0; p < N_PHASES; ++p) { a.ph_lo = p; a.ph_hi = p + 1; hipLaunchKernelGGL(yoco_fwd, dim3(grid), dim3(NTHREADS), LDS_BYTES, stream, a); }
#endif
}
```
